# Optimizing an MI355X kernel written in HIP

```python
import math
import jax
import jax.numpy as jnp
from jax import lax
import numpy as np

D_MODEL = 1024
BATCH = 2
SEQ = 8192
DEPTH = 1

MIX_WIDTH = D_MODEL
GM_WIDTH = MIX_WIDTH // 2
GM_HEADS = 4
GM_HEAD_DIM = GM_WIDTH // GM_HEADS
CHUNK = 128
DA_WIDTH = MIX_WIDTH - GM_WIDTH
DA_HEADS = 4
DA_VDIM = DA_WIDTH // DA_HEADS
DA_QKDIM = DA_VDIM // 2
LAMBDA_INIT = 0.8 - 0.6 * math.exp(-0.3 * (1 - 1))
Q_BLOCK = 128
IN_COLS = 2 * GM_WIDTH + 3 * DA_WIDTH
PEER_HEADS = 8
N_KEYS = 128
N_EXPERTS = N_KEYS * N_KEYS
PEER_QDIM = 256
PEER_HALF = PEER_QDIM // 2
PEER_TOPK = 16
TOK_BLOCK = 128
ALPHA = (2.0 * DEPTH) ** 0.25
BETA = (8.0 * DEPTH) ** -0.25
LN_EPS = 1e-5
NEG_INF = -1e30

kernel_name = "hybrid_gmlp_diffattn_peer_deepnorm"


def _layer_norm(x, g, b):
    xf = x.astype(jnp.float32)
    mu = jnp.mean(xf, axis=-1, keepdims=True)
    var = jnp.mean(jnp.square(xf - mu), axis=-1, keepdims=True)
    y = (xf - mu) * lax.rsqrt(var + LN_EPS)
    return (y * g.astype(jnp.float32) + b.astype(jnp.float32)).astype(x.dtype)


def _rms_norm_heads(x, g):
    xf = x.astype(jnp.float32)
    y = xf * lax.rsqrt(jnp.mean(jnp.square(xf), axis=-1, keepdims=True) + LN_EPS)
    return (y * g.astype(jnp.float32)[None, :, None, :]).astype(x.dtype)


def _gmlp_chunked(z, norm_g, norm_b, w_s, b_s):
    B, S, _ = z.shape
    nc = S // CHUNK
    u = z[..., :GM_WIDTH]
    v = _layer_norm(z[..., GM_WIDTH:], norm_g, norm_b)
    v = v.reshape(B, nc, CHUNK, GM_HEADS, GM_HEAD_DIM)
    mask = jnp.tril(jnp.ones((CHUNK, CHUNK), dtype=w_s.dtype))
    w_causal = w_s * mask[None]
    mixed = jnp.einsum('hts,bnshc->bnthc', w_causal, v) + b_s.T[None, None, :, :, None]
    out = u.reshape(B, nc, CHUNK, GM_HEADS, GM_HEAD_DIM) * mixed
    return out.reshape(B, S, GM_WIDTH)


def _diff_attention(q1, q2, k1, k2, v, lam):
    B, H, S, dk = q1.shape
    dv = v.shape[-1]
    nb = S // Q_BLOCK
    slopes = 2.0 ** (-(8.0 / H) * jnp.arange(1, H + 1, dtype=jnp.float32))
    kpos = jnp.arange(S, dtype=jnp.int32)
    scale = dk ** -0.5

    def block(args):
        qb1, qb2, start = args
        qpos = start + jnp.arange(Q_BLOCK, dtype=jnp.int32)
        dist = (qpos[:, None] - kpos[None, :]).astype(jnp.float32)
        bias = -slopes[:, None, None] * dist
        causal = dist >= 0

        def probs(qb, k):
            logits = jnp.einsum('bhqd,bhkd->bhqk', qb, k).astype(jnp.float32) * scale + bias
            logits = jnp.where(causal, logits, NEG_INF)
            return jax.nn.softmax(logits, axis=-1)

        a = probs(qb1, k1) - lam * probs(qb2, k2)
        return jnp.einsum('bhqk,bhkd->bhqd', a.astype(v.dtype), v)

    qb1 = q1.reshape(B, H, nb, Q_BLOCK, dk).transpose(2, 0, 1, 3, 4)
    qb2 = q2.reshape(B, H, nb, Q_BLOCK, dk).transpose(2, 0, 1, 3, 4)
    starts = jnp.arange(nb, dtype=jnp.int32) * Q_BLOCK
    out = lax.map(block, (qb1, qb2, starts))
    return out.transpose(1, 2, 0, 3, 4).reshape(B, H, S, dv)


def _peer(x, w_q, keys_a, keys_b, u_tab, v_tab):
    B, S, D = x.shape
    q = (x @ w_q).reshape(B, S, PEER_HEADS, 2, PEER_HALF)
    sa = jnp.einsum('bshd,hkd->bshk', q[..., 0, :], keys_a).astype(jnp.float32)
    sb = jnp.einsum('bshd,hkd->bshk', q[..., 1, :], keys_b).astype(jnp.float32)
    va, ia = lax.top_k(sa, PEER_TOPK)
    vb, ib = lax.top_k(sb, PEER_TOPK)
    cand = (va[..., :, None] + vb[..., None, :]).reshape(B, S, PEER_HEADS, PEER_TOPK * PEER_TOPK)
    s, ci = lax.top_k(cand, PEER_TOPK)
    ea = jnp.take_along_axis(ia, ci // PEER_TOPK, axis=-1)
    eb = jnp.take_along_axis(ib, ci % PEER_TOPK, axis=-1)
    expert = ea * N_KEYS + eb
    g = jax.nn.softmax(s, axis=-1)
    T = B * S
    nblk = T // TOK_BLOCK
    xt = x.reshape(nblk, TOK_BLOCK, D)
    et = expert.reshape(nblk, TOK_BLOCK, PEER_HEADS * PEER_TOPK)
    gt = g.reshape(nblk, TOK_BLOCK, PEER_HEADS * PEER_TOPK).astype(x.dtype)

    def blk(args):
        xb, eidx, gb = args
        ub = u_tab[eidx]
        h = jax.nn.gelu(jnp.einsum('tkd,td->tk', ub, xb), approximate=False)
        return jnp.einsum('tk,tkd->td', gb * h, v_tab[eidx])

    out = lax.map(blk, (xt, et, gt))
    return out.reshape(B, S, D)


def setup_inputs(seed: int = 0) -> dict:
    key = jax.random.key(seed)
    ks = jax.random.split(key, 24)
    f32 = jnp.float32
    nrm = lambda k, shape, s: jax.random.normal(k, shape, f32) * s
    return {
        "x": nrm(ks[0], (BATCH, SEQ, D_MODEL), 1.0),
        "w_in": nrm(ks[1], (D_MODEL, IN_COLS), D_MODEL ** -0.5),
        "gm_norm_g": 1.0 + nrm(ks[2], (GM_WIDTH,), 0.02),
        "gm_norm_b": nrm(ks[3], (GM_WIDTH,), 0.02),
        "gm_w_s": nrm(ks[4], (GM_HEADS, CHUNK, CHUNK), CHUNK ** -0.5),
        "gm_b_s": 1.0 + nrm(ks[5], (GM_HEADS, CHUNK), 0.02),
        "lam_q1": nrm(ks[6], (DA_QKDIM,), 0.1),
        "lam_k1": nrm(ks[7], (DA_QKDIM,), 0.1),
        "lam_q2": nrm(ks[8], (DA_QKDIM,), 0.1),
        "lam_k2": nrm(ks[9], (DA_QKDIM,), 0.1),
        "da_norm_g": 1.0 + nrm(ks[10], (DA_HEADS, DA_VDIM), 0.02),
        "w_o": nrm(ks[11], (MIX_WIDTH, D_MODEL), BETA * MIX_WIDTH ** -0.5),
        "ln1_g": 1.0 + nrm(ks[12], (D_MODEL,), 0.02),
        "ln1_b": nrm(ks[13], (D_MODEL,), 0.02),
        "peer_w_q": nrm(ks[14], (D_MODEL, PEER_HEADS * PEER_QDIM), D_MODEL ** -0.5),
        "peer_keys_a": nrm(ks[15], (PEER_HEADS, N_KEYS, PEER_HALF), PEER_HALF ** -0.5),
        "peer_keys_b": nrm(ks[16], (PEER_HEADS, N_KEYS, PEER_HALF), PEER_HALF ** -0.5),
        "peer_u": nrm(ks[17], (N_EXPERTS, D_MODEL), D_MODEL ** -0.5),
        "peer_v": nrm(ks[18], (N_EXPERTS, D_MODEL), BETA * PEER_HEADS ** -0.5),
        "ln2_g": 1.0 + nrm(ks[19], (D_MODEL,), 0.02),
        "ln2_b": nrm(ks[20], (D_MODEL,), 0.02),
    }


def reference(x, w_in, gm_norm_g, gm_norm_b, gm_w_s, gm_b_s, lam_q1, lam_k1, lam_q2, lam_k2,
              da_norm_g, w_o, ln1_g, ln1_b, peer_w_q, peer_keys_a, peer_keys_b, peer_u, peer_v,
              ln2_g, ln2_b):
    B, S, D = x.shape
    for _ in range(DEPTH):
        h = x @ w_in
        z = jax.nn.gelu(h[..., :2 * GM_WIDTH], approximate=False)
        y_gm = _gmlp_chunked(z, gm_norm_g, gm_norm_b, gm_w_s, gm_b_s)
        o = 2 * GM_WIDTH
        q = h[..., o:o + DA_WIDTH].reshape(B, S, DA_HEADS, 2, DA_QKDIM).transpose(0, 2, 1, 3, 4)
        k = h[..., o + DA_WIDTH:o + 2 * DA_WIDTH].reshape(B, S, DA_HEADS, 2, DA_QKDIM).transpose(0, 2, 1, 3, 4)
        v = h[..., o + 2 * DA_WIDTH:o + 3 * DA_WIDTH].reshape(B, S, DA_HEADS, DA_VDIM).transpose(0, 2, 1, 3)
        lam = (jnp.exp(jnp.sum(lam_q1.astype(jnp.float32) * lam_k1.astype(jnp.float32)))
               - jnp.exp(jnp.sum(lam_q2.astype(jnp.float32) * lam_k2.astype(jnp.float32)))
               + LAMBDA_INIT)
        att = _diff_attention(q[..., 0, :], q[..., 1, :], k[..., 0, :], k[..., 1, :], v, lam)
        att = _rms_norm_heads(att, da_norm_g) * (1.0 - LAMBDA_INIT)
        y_da = att.transpose(0, 2, 1, 3).reshape(B, S, DA_WIDTH)
        mix = jnp.concatenate([y_gm, y_da], axis=-1) @ w_o
        x = _layer_norm(ALPHA * x + mix, ln1_g, ln1_b)
        ffn = _peer(x, peer_w_q, peer_keys_a, peer_keys_b, peer_u, peer_v)
        x = _layer_norm(ALPHA * x + ffn, ln2_g, ln2_b)
    return x
```

```cpp
#include <hip/hip_runtime.h>
#include <hip/hip_cooperative_groups.h>
#include <cstdio>
namespace cg = cooperative_groups;
#define MULTI_LAUNCH 1

#define DI __device__ __forceinline__
typedef unsigned short u16;
typedef unsigned int u32;
typedef __attribute__((ext_vector_type(2))) __bf16 bf2_t;
typedef __attribute__((ext_vector_type(2))) float f2_t;
typedef __attribute__((ext_vector_type(2))) _Float16 h2_t;
typedef __attribute__((ext_vector_type(8))) _Float16 h8_t;
typedef __attribute__((ext_vector_type(8))) short s8_t;
typedef __attribute__((ext_vector_type(16))) float f32x16;
typedef __attribute__((ext_vector_type(4))) u32 u32x4;
typedef __attribute__((ext_vector_type(2))) u32 u32x2;
typedef __attribute__((ext_vector_type(4))) float f32x4;

constexpr int T_TOK = 16384;
constexpr int SEQ = 8192;
constexpr float ALPHA = 1.189207115002721f;
constexpr float LN_EPS = 1e-5f;
constexpr float LOG2E = 1.4426950408889634f;

struct Params {
  const float *x, *w_in, *gm_g, *gm_b, *gm_ws, *gm_bs, *lq1, *lk1, *lq2, *lk2, *da_g, *w_o, *ln1g, *ln1b,
      *w_q, *keys_a, *keys_b, *pu, *pv, *ln2g, *ln2b;
  float* out;
  u16 *xb, *mixcat, *u16t, *v16t, *zu, *zvT, *qb, *kb, *vT, *x1h, *w_inT, *w_oT, *w_qT, *keysh, *wsb;
  float* x1f;
  int* eid;
  float* gate;
};

DI u32 pack_bf2(float a, float b) { f2_t v = {a, b}; bf2_t r = __builtin_convertvector(v, bf2_t); return __builtin_bit_cast(u32, r); }
DI u32 pack_h2(float a, float b) { f2_t v = {a, b}; h2_t r = __builtin_convertvector(v, h2_t); return __builtin_bit_cast(u32, r); }
DI float bf_lo(u32 u) { return __uint_as_float(u << 16); }
DI float bf_hi(u32 u) { return __uint_as_float(u & 0xffff0000u); }
DI float bf2f(u16 u) { return __uint_as_float(((u32)u) << 16); }
DI float gelu_f(float x) { return 0.5f * x * (1.f + erff(x * 0.70710678118654752f)); }
DI int crow(int i, int h) { return (i & 3) + 8 * (i >> 2) + 4 * h; }

template <bool F16>
DI f32x16 mfma32(u32x4 a, u32x4 b, f32x16 c) {
  if constexpr (F16)
    return __builtin_amdgcn_mfma_f32_32x32x16_f16(__builtin_bit_cast(h8_t, a), __builtin_bit_cast(h8_t, b), c, 0, 0, 0);
  else
    return __builtin_amdgcn_mfma_f32_32x32x16_bf16(__builtin_bit_cast(s8_t, a), __builtin_bit_cast(s8_t, b), c, 0, 0, 0);
}

template <int TM, int TN, bool F16>
DI void gemm_tile(const u16* __restrict__ A, int lda, const u16* __restrict__ B, int ldb, int K,
                  f32x16 (&acc)[TM][TN], char* smem) {
  constexpr int BM = 64 * TM, BN = 64 * TN;
  constexpr int NA = BM * 8 / 256, NB = BN * 8 / 256;
  const int tid = threadIdx.x, lane = tid & 63, w = tid >> 6, wm = w >> 1, wn = w & 1, r = lane & 31, h = lane >> 5;
  u16* sA = (u16*)smem;
  u16* sB = sA + BM * 72;
  u32x4 ra[NA], rb[NB];
  const u16* ag = A + (size_t)(tid >> 3) * lda + (tid & 7) * 8;
  const u16* bg = B + (size_t)(tid >> 3) * ldb + (tid & 7) * 8;
#pragma unroll
  for (int i = 0; i < NA; ++i) ra[i] = *(const u32x4*)(ag + (size_t)(32 * i) * lda);
#pragma unroll
  for (int i = 0; i < NB; ++i) rb[i] = *(const u32x4*)(bg + (size_t)(32 * i) * ldb);
  for (int k0 = 0; k0 < K; k0 += 64) {
    __syncthreads();
#pragma unroll
    for (int i = 0; i < NA; ++i) *(u32x4*)(sA + ((tid >> 3) + 32 * i) * 72 + (tid & 7) * 8) = ra[i];
#pragma unroll
    for (int i = 0; i < NB; ++i) *(u32x4*)(sB + ((tid >> 3) + 32 * i) * 72 + (tid & 7) * 8) = rb[i];
    __syncthreads();
    if (k0 + 64 < K) {
#pragma unroll
      for (int i = 0; i < NA; ++i) ra[i] = *(const u32x4*)(ag + (size_t)(32 * i) * lda + k0 + 64);
#pragma unroll
      for (int i = 0; i < NB; ++i) rb[i] = *(const u32x4*)(bg + (size_t)(32 * i) * ldb + k0 + 64);
    }
#pragma unroll
    for (int ks = 0; ks < 4; ++ks) {
      u32x4 af[TM], bfr[TN];
#pragma unroll
      for (int mt = 0; mt < TM; ++mt) af[mt] = *(const u32x4*)(sA + (wm * 32 * TM + mt * 32 + r) * 72 + ks * 16 + 8 * h);
#pragma unroll
      for (int nt = 0; nt < TN; ++nt) bfr[nt] = *(const u32x4*)(sB + (wn * 32 * TN + nt * 32 + r) * 72 + ks * 16 + 8 * h);
#pragma unroll
      for (int mt = 0; mt < TM; ++mt)
#pragma unroll
        for (int nt = 0; nt < TN; ++nt) acc[mt][nt] = mfma32<F16>(af[mt], bfr[nt], acc[mt][nt]);
    }
  }
}

template <bool F16>
DI void cvt8(const float* __restrict__ src, u16* __restrict__ dst, size_t i8) {
  const f32x4 a = *(const f32x4*)(src + i8 * 8), b = *(const f32x4*)(src + i8 * 8 + 4);
  u32x4 o;
  if constexpr (F16) { o[0] = pack_h2(a[0], a[1]); o[1] = pack_h2(a[2], a[3]); o[2] = pack_h2(b[0], b[1]); o[3] = pack_h2(b[2], b[3]); }
  else { o[0] = pack_bf2(a[0], a[1]); o[1] = pack_bf2(a[2], a[3]); o[2] = pack_bf2(b[0], b[1]); o[3] = pack_bf2(b[2], b[3]); }
  *(u32x4*)(dst + i8 * 8) = o;
}

template <bool F16>
DI void transpose_tile(const float* __restrict__ W, int N, u16* __restrict__ WT, int kt, int nt, char* smem) {
  float* sT = (float*)smem;
  const int tid = threadIdx.x;
  __syncthreads();
#pragma unroll
  for (int i = 0; i < 4; ++i) {
    const int row = (tid >> 4) + 16 * i, c4 = (tid & 15) * 4;
    const f32x4 v = *(const f32x4*)(W + (size_t)(kt * 64 + row) * N + nt * 64 + c4);
    sT[row * 65 + c4 + 0] = v[0]; sT[row * 65 + c4 + 1] = v[1]; sT[row * 65 + c4 + 2] = v[2]; sT[row * 65 + c4 + 3] = v[3];
  }
  __syncthreads();
  const int n = tid >> 2, ks = (tid & 3) * 16;
  u32 o[8];
#pragma unroll
  for (int j = 0; j < 8; ++j) {
    const float a = sT[(ks + 2 * j) * 65 + n], b = sT[(ks + 2 * j + 1) * 65 + n];
    o[j] = F16 ? pack_h2(a, b) : pack_bf2(a, b);
  }
  u16* d = WT + (size_t)(nt * 64 + n) * 1024 + kt * 64 + ks;
  *(u32x4*)d = (u32x4){o[0], o[1], o[2], o[3]};
  *(u32x4*)(d + 8) = (u32x4){o[4], o[5], o[6], o[7]};
}

DI void phase0(const Params& p, char* smem) {
  const size_t gt = (size_t)blockIdx.x * 256 + threadIdx.x, gs = (size_t)gridDim.x * 256;
  for (size_t i = gt; i < (size_t)T_TOK * 1024 / 8; i += gs) {
    cvt8<false>(p.x, p.xb, i);
    cvt8<true>(p.pu, p.u16t, i);
    cvt8<true>(p.pv, p.v16t, i);
  }
  for (size_t i = gt; i < 131072 / 8; i += gs) { cvt8<true>(p.keys_a, p.keysh, i); cvt8<true>(p.keys_b, p.keysh + 131072, i); }
  for (size_t i = gt; i < 65536; i += gs) {
    const int t = (i >> 7) & 127, s = i & 127;
    p.wsb[i] = (u16)(pack_bf2(s <= t ? p.gm_ws[i] : 0.f, 0.f) & 0xffff);
  }
  for (int t = blockIdx.x; t < 640 + 256 + 512; t += gridDim.x) {
    if (t < 640) transpose_tile<false>(p.w_in, 2560, p.w_inT, t / 40, t % 40, smem);
    else if (t < 896) transpose_tile<false>(p.w_o, 1024, p.w_oT, (t - 640) / 16, (t - 640) % 16, smem);
    else transpose_tile<true>(p.w_q, 2048, p.w_qT, (t - 896) / 32, (t - 896) % 32, smem);
  }
}

DI void phase1(const Params& p, char* smem) {
  const int lane = threadIdx.x & 63, w = threadIdx.x >> 6, wm = w >> 1, wn = w & 1, r = lane & 31, h = lane >> 5;
  for (int t = blockIdx.x; t < 128 * 20; t += gridDim.x) {
    const int mt_ = t / 20, nt_ = t % 20;
    const int m0 = mt_ * 128, n0 = nt_ * 128;
    const bool swapped = (n0 >= 512 && n0 < 1024) || (n0 >= 2048);
    f32x16 acc[2][2];
#pragma unroll
    for (int a = 0; a < 2; ++a)
#pragma unroll
      for (int b = 0; b < 2; ++b)
#pragma unroll
        for (int i = 0; i < 16; ++i) acc[a][b][i] = 0.f;
    if (!swapped) {
      gemm_tile<2, 2, false>(p.xb + (size_t)m0 * 1024, 1024, p.w_inT + (size_t)n0 * 1024, 1024, 1024, acc, smem);
      u16* dst; int cb; int mode;
      if (n0 < 512) { dst = p.zu; cb = n0; mode = 0; }
      else if (n0 < 1536) { dst = p.qb; cb = n0 - 1024; mode = 1; }
      else { dst = p.kb; cb = n0 - 1536; mode = 2; }
#pragma unroll
      for (int a = 0; a < 2; ++a)
#pragma unroll
        for (int b = 0; b < 2; ++b)
#pragma unroll
          for (int i = 0; i < 16; ++i) {
            const int row = m0 + wm * 64 + a * 32 + crow(i, h), col = cb + wn * 64 + b * 32 + r;
            float v = acc[a][b][i];
            if (mode == 0) v = gelu_f(v);
            else if (mode == 1) v *= 0.125f * LOG2E;
            dst[(size_t)row * 512 + col] = (u16)(pack_bf2(v, 0.f) & 0xffff);
          }
    } else {
      gemm_tile<2, 2, false>(p.w_inT + (size_t)n0 * 1024, 1024, p.xb + (size_t)m0 * 1024, 1024, 1024, acc, smem);
      const bool isz = n0 < 1024;
      u16* dst = isz ? p.zvT : p.vT;
      const int cb = isz ? n0 - 512 : n0 - 2048;
      const int bb = m0 >> 13, s0 = m0 & 8191;
#pragma unroll
      for (int a = 0; a < 2; ++a)
#pragma unroll
        for (int b = 0; b < 2; ++b)
#pragma unroll
          for (int i = 0; i < 16; ++i) {
            const int col = cb + wm * 64 + a * 32 + crow(i, h), s = s0 + wn * 64 + b * 32 + r;
            float v = acc[a][b][i];
            if (isz) v = gelu_f(v);
            dst[((size_t)bb * 512 + col) * SEQ + s] = (u16)(pack_bf2(v, 0.f) & 0xffff);
          }
    }
  }
}

DI void gmlp_unit(const Params& p, int chunk, int hh, char* smem) {
  const int tid = threadIdx.x, lane = tid & 63, w = tid >> 6, wm = w >> 1, wn = w & 1, r = lane & 31, h = lane >> 5;
  const int tok0 = chunk * 128, bb = tok0 >> 13, s0 = tok0 & 8191;
  float* sMu = (float*)smem;
  float* sRs = sMu + 128;
  float* sPart = sRs + 128;
  u16* sA = (u16*)(smem + 17408);
  u16* sB = sA + 128 * 72;
  __syncthreads();
  {
    const int c = tid & 15, cg_ = tid >> 4;
    float sm[8], sq[8];
#pragma unroll
    for (int j = 0; j < 8; ++j) { sm[j] = 0.f; sq[j] = 0.f; }
    for (int i = 0; i < 32; ++i) {
      const int ch = cg_ + 16 * i;
      const u32x4 v = *(const u32x4*)(p.zvT + ((size_t)bb * 512 + ch) * SEQ + s0 + c * 8);
#pragma unroll
      for (int j = 0; j < 4; ++j) {
        const float a = bf_lo(v[j]), b = bf_hi(v[j]);
        sm[2 * j] += a; sq[2 * j] += a * a; sm[2 * j + 1] += b; sq[2 * j + 1] += b * b;
      }
    }
#pragma unroll
    for (int j = 0; j < 8; ++j) { sPart[(cg_ * 128 + c * 8 + j) * 2] = sm[j]; sPart[(cg_ * 128 + c * 8 + j) * 2 + 1] = sq[j]; }
    __syncthreads();
    if (tid < 128) {
      float a = 0.f, b = 0.f;
      for (int g = 0; g < 16; ++g) { a += sPart[(g * 128 + tid) * 2]; b += sPart[(g * 128 + tid) * 2 + 1]; }
      const float mu = a * (1.f / 512.f);
      const float var = fmaxf(b * (1.f / 512.f) - mu * mu, 0.f);
      sMu[tid] = mu; sRs[tid] = rsqrtf(var + LN_EPS);
    }
  }
  f32x16 acc[2][2];
#pragma unroll
  for (int a = 0; a < 2; ++a)
#pragma unroll
    for (int b = 0; b < 2; ++b)
#pragma unroll
      for (int i = 0; i < 16; ++i) acc[a][b][i] = 0.f;
  for (int kh = 0; kh < 2; ++kh) {
    __syncthreads();
#pragma unroll
    for (int i = 0; i < 4; ++i) {
      const int idx = tid + 256 * i, row = idx >> 3, c = idx & 7;
      *(u32x4*)(sA + row * 72 + c * 8) = *(const u32x4*)(p.wsb + (size_t)hh * 16384 + row * 128 + kh * 64 + c * 8);
      const int ch = hh * 128 + row;
      const u32x4 v = *(const u32x4*)(p.zvT + ((size_t)bb * 512 + ch) * SEQ + s0 + kh * 64 + c * 8);
      const float g = p.gm_g[ch], be = p.gm_b[ch];
      u32x4 o;
#pragma unroll
      for (int j = 0; j < 4; ++j) {
        const int s = kh * 64 + c * 8 + 2 * j;
        const float a = (bf_lo(v[j]) - sMu[s]) * sRs[s] * g + be;
        const float b = (bf_hi(v[j]) - sMu[s + 1]) * sRs[s + 1] * g + be;
        o[j] = pack_bf2(a, b);
      }
      *(u32x4*)(sB + row * 72 + c * 8) = o;
    }
    __syncthreads();
#pragma unroll
    for (int ks = 0; ks < 4; ++ks) {
      u32x4 af[2], bfr[2];
#pragma unroll
      for (int mt = 0; mt < 2; ++mt) af[mt] = *(const u32x4*)(sA + (wm * 64 + mt * 32 + r) * 72 + ks * 16 + 8 * h);
#pragma unroll
      for (int nt = 0; nt < 2; ++nt) bfr[nt] = *(const u32x4*)(sB + (wn * 64 + nt * 32 + r) * 72 + ks * 16 + 8 * h);
#pragma unroll
      for (int mt = 0; mt < 2; ++mt)
#pragma unroll
        for (int nt = 0; nt < 2; ++nt) acc[mt][nt] = mfma32<false>(af[mt], bfr[nt], acc[mt][nt]);
    }
  }
#pragma unroll
  for (int a = 0; a < 2; ++a)
#pragma unroll
    for (int b = 0; b < 2; ++b)
#pragma unroll
      for (int i = 0; i < 16; ++i) {
        const int t = wm * 64 + a * 32 + crow(i, h), ch = wn * 64 + b * 32 + r;
        const float mixed = acc[a][b][i] + p.gm_bs[hh * 128 + t];
        const float u = bf2f(p.zu[(size_t)(tok0 + t) * 512 + hh * 128 + ch]);
        p.mixcat[(size_t)(tok0 + t) * 1024 + hh * 128 + ch] = (u16)(pack_bf2(u * mixed, 0.f) & 0xffff);
      }
}

DI void attn_unit(const Params& p, int bb, int hh, int qt, float lam, char* smem) {
  const int tid = threadIdx.x, lane = tid & 63, w = tid >> 6, r = lane & 31, h = lane >> 5;
  const int map = w >> 1, qs = w & 1;
  u16* sK = (u16*)smem;
  u16* sV = sK + 64 * 136;
  const size_t tok0 = (size_t)bb * SEQ;
  const int q0 = qt * 64;
  const float slope2 = exp2f(-2.f * (float)(hh + 1)) * LOG2E;
  u32x4 qf[4];
  {
    const u16* qptr = p.qb + (tok0 + q0 + qs * 32 + r) * 512 + hh * 128 + map * 64 + 8 * h;
#pragma unroll
    for (int ks = 0; ks < 4; ++ks) qf[ks] = *(const u32x4*)(qptr + ks * 16);
  }
  f32x16 O[4];
#pragma unroll
  for (int d = 0; d < 4; ++d)
#pragma unroll
    for (int i = 0; i < 16; ++i) O[d][i] = 0.f;
  float m = -1e30f, l = 0.f;
  u32x4 rk[4], rv[4];
  const u16* kg = p.kb + (tok0 + (tid >> 4)) * 512 + hh * 128 + (tid & 15) * 8;
  const u16* vg = p.vT + ((size_t)(bb * 4 + hh) * 128 + (tid >> 3)) * SEQ + (tid & 7) * 8;
#pragma unroll
  for (int i = 0; i < 4; ++i) { rk[i] = *(const u32x4*)(kg + (size_t)(16 * i) * 512); rv[i] = *(const u32x4*)(vg + (size_t)(32 * i) * SEQ); }
  const int kr = (r & ~12) | ((r & 4) << 1) | ((r & 8) >> 1);
  const float hb = slope2 * (float)(8 * h);
  for (int kt = 0; kt <= qt; ++kt) {
    __syncthreads();
#pragma unroll
    for (int i = 0; i < 4; ++i) {
      *(u32x4*)(sK + ((tid >> 4) + 16 * i) * 136 + (tid & 15) * 8) = rk[i];
      *(u32x4*)(sV + ((tid >> 3) + 32 * i) * 72 + (tid & 7) * 8) = rv[i];
    }
    __syncthreads();
    if (kt < qt) {
#pragma unroll
      for (int i = 0; i < 4; ++i) {
        rk[i] = *(const u32x4*)(kg + (size_t)((kt + 1) * 64 + 16 * i) * 512);
        rv[i] = *(const u32x4*)(vg + (size_t)(32 * i) * SEQ + (kt + 1) * 64);
      }
    }
    f32x16 S[2];
    {
      float hb2 = hb, sl = slope2;
      asm volatile("" : "+v"(hb2), "+v"(sl));
#pragma unroll
      for (int mt = 0; mt < 2; ++mt)
#pragma unroll
        for (int i = 0; i < 16; ++i) {
          if ((i & 7) == 0) S[mt][i] = hb2 + sl * (float)(32 * mt + 16 * (i >> 3));
          else S[mt][i] = S[mt][i - 1] + sl;
        }
    }
#pragma unroll
    for (int mt = 0; mt < 2; ++mt)
#pragma unroll
      for (int ks = 0; ks < 4; ++ks) {
        const u32x4 a = *(const u32x4*)(sK + (mt * 32 + kr) * 136 + map * 64 + ks * 16 + 8 * h);
        S[mt] = mfma32<false>(a, qf[ks], S[mt]);
      }
    if (kt > 0) m -= slope2 * 64.f;
    if (kt == qt) {
      const int qrel = qs * 32 + r;
#pragma unroll
      for (int mt = 0; mt < 2; ++mt)
#pragma unroll
        for (int i = 0; i < 16; ++i) {
          const int keyrel = 32 * mt + 16 * (i >> 3) + 8 * h + (i & 7);
          if (keyrel > qrel) S[mt][i] = -1e30f;
        }
    }
    float mx = S[0][0];
#pragma unroll
    for (int i = 1; i < 16; ++i) mx = fmaxf(mx, S[0][i]);
#pragma unroll
    for (int i = 0; i < 16; ++i) mx = fmaxf(mx, S[1][i]);
    mx = fmaxf(mx, __shfl_xor(mx, 32));
    const float mn = fmaxf(m, mx);
    const float alpha = __builtin_amdgcn_exp2f(m - mn);
    m = mn;
    float ls = 0.f;
#pragma unroll
    for (int mt = 0; mt < 2; ++mt)
#pragma unroll
      for (int i = 0; i < 16; ++i) { const float e = __builtin_amdgcn_exp2f(S[mt][i] - mn); S[mt][i] = e; ls += e; }
    l = l * alpha + ls;
#pragma unroll
    for (int d = 0; d < 4; ++d)
#pragma unroll
      for (int i = 0; i < 16; ++i) O[d][i] *= alpha;
#pragma unroll
    for (int mt = 0; mt < 2; ++mt)
#pragma unroll
      for (int s = 0; s < 2; ++s) {
        u32x4 pf;
#pragma unroll
        for (int j = 0; j < 4; ++j) pf[j] = pack_bf2(S[mt][8 * s + 2 * j], S[mt][8 * s + 2 * j + 1]);
#pragma unroll
        for (int d = 0; d < 4; ++d) {
          const u32x4 a = *(const u32x4*)(sV + (d * 32 + r) * 72 + mt * 32 + s * 16 + 8 * h);
          O[d] = mfma32<false>(a, pf, O[d]);
        }
      }
  }
  l += __shfl_xor(l, 32);
  const float inv = 1.f / l;
  __syncthreads();
  float* sC = (float*)smem;
  if (map == 1) {
    const float sc = inv * lam;
#pragma unroll
    for (int d = 0; d < 4; ++d)
#pragma unroll
      for (int i = 0; i < 16; ++i) sC[(qs * 64 + d * 16 + i) * 64 + lane] = O[d][i] * sc;
  }
  __syncthreads();
  if (map == 0) {
    float ss = 0.f;
#pragma unroll
    for (int d = 0; d < 4; ++d)
#pragma unroll
      for (int i = 0; i < 16; ++i) {
        const float v = O[d][i] * inv - sC[(qs * 64 + d * 16 + i) * 64 + lane];
        O[d][i] = v; ss += v * v;
      }
    ss += __shfl_xor(ss, 32);
    const float rs = rsqrtf(ss * (1.f / 128.f) + LN_EPS) * 0.8f;
    u16* dst = p.mixcat + (tok0 + q0 + qs * 32 + r) * 1024 + 512 + hh * 128;
#pragma unroll
    for (int d = 0; d < 4; ++d)
#pragma unroll
      for (int i4 = 0; i4 < 4; ++i4) {
        const int dv0 = d * 32 + 8 * i4 + 4 * h;
        const f32x4 g = *(const f32x4*)(p.da_g + hh * 128 + dv0);
        u32x2 o;
        o[0] = pack_bf2(O[d][4 * i4] * rs * g[0], O[d][4 * i4 + 1] * rs * g[1]);
        o[1] = pack_bf2(O[d][4 * i4 + 2] * rs * g[2], O[d][4 * i4 + 3] * rs * g[3]);
        *(u32x2*)(dst + dv0) = o;
      }
  }
}

DI void phase2(const Params& p, char* smem) {
  float lam;
  {
    float a = 0.f, b = 0.f;
    for (int i = 0; i < 64; ++i) { a += p.lq1[i] * p.lk1[i]; b += p.lq2[i] * p.lk2[i]; }
    lam = expf(a) - expf(b) + 0.2f;
  }
  const int G = gridDim.x, j = blockIdx.x;
  for (int k = 0; k * G < 1024; ++k) {
    const int i = (k & 1) ? (k * G + (G - 1 - j)) : (k * G + j);
    if (i < 1024) {
      const int qt = 127 - (i >> 3), bh = i & 7;
      attn_unit(p, bh >> 2, bh & 3, qt, lam, smem);
    }
  }
  for (int u = G - 1 - j; u < 512; u += G) gmlp_unit(p, u >> 2, u & 3, smem);
}

DI void phase3(const Params& p, char* smem) {
  const int lane = threadIdx.x & 63, w = threadIdx.x >> 6, wm = w >> 1, wn = w & 1, r = lane & 31, h = lane >> 5;
  for (int u = blockIdx.x; u < 256; u += gridDim.x) {
    const int row0 = u * 64;
    for (int nt_ = 0; nt_ < 8; ++nt_) {
      f32x16 acc[1][2];
#pragma unroll
      for (int b = 0; b < 2; ++b)
#pragma unroll
        for (int i = 0; i < 16; ++i) acc[0][b][i] = 0.f;
      gemm_tile<1, 2, false>(p.mixcat + (size_t)row0 * 1024, 1024, p.w_oT + (size_t)nt_ * 128 * 1024, 1024, 1024, acc, smem);
#pragma unroll
      for (int b = 0; b < 2; ++b)
#pragma unroll
        for (int i = 0; i < 16; ++i) {
          const size_t o = (size_t)(row0 + wm * 32 + crow(i, h)) * 1024 + nt_ * 128 + wn * 64 + b * 32 + r;
          p.x1f[o] = ALPHA * p.x[o] + acc[0][b][i];
        }
    }
    __threadfence();
    __syncthreads();
    for (int j = 0; j < 16; ++j) {
      const size_t ro = (size_t)(row0 + w * 16 + j) * 1024;
      f32x4 v[4];
      float s = 0.f;
#pragma unroll
      for (int i = 0; i < 4; ++i) {
        v[i] = *(const f32x4*)(p.x1f + ro + i * 256 + lane * 4);
        s += v[i][0] + v[i][1] + v[i][2] + v[i][3];
      }
#pragma unroll
      for (int o = 32; o > 0; o >>= 1) s += __shfl_xor(s, o);
      const float mu = s * (1.f / 1024.f);
      float q = 0.f;
#pragma unroll
      for (int i = 0; i < 4; ++i)
#pragma unroll
        for (int c = 0; c < 4; ++c) { const float d = v[i][c] - mu; q += d * d; }
#pragma unroll
      for (int o = 32; o > 0; o >>= 1) q += __shfl_xor(q, o);
      const float rs = rsqrtf(q * (1.f / 1024.f) + LN_EPS);
#pragma unroll
      for (int i = 0; i < 4; ++i) {
        const int col = i * 256 + lane * 4;
        const f32x4 g = *(const f32x4*)(p.ln1g + col), be = *(const f32x4*)(p.ln1b + col);
        f32x4 y;
#pragma unroll
        for (int c = 0; c < 4; ++c) y[c] = (v[i][c] - mu) * rs * g[c] + be[c];
        *(f32x4*)(p.x1f + ro + col) = y;
        u32x2 hv; hv[0] = pack_h2(y[0], y[1]); hv[1] = pack_h2(y[2], y[3]);
        *(u32x2*)(p.x1h + ro + col) = hv;
      }
    }
    __syncthreads();
  }
}

DI u32 f2key(float f) { const u32 u = __float_as_uint(f); return (u & 0x80000000u) ? ~u : (u | 0x80000000u); }
DI float key2f(u32 k) { return __uint_as_float((k & 0x80000000u) ? (k & 0x7fffffffu) : ~k); }
DI u32 umax(u32 a, u32 b) { return a > b ? a : b; }
DI u32 umin(u32 a, u32 b) { return a < b ? a : b; }

DI void sort16_desc(u32 (&v)[16]) {
#pragma unroll
  for (int k = 2; k <= 16; k <<= 1)
#pragma unroll
    for (int j = k >> 1; j > 0; j >>= 1)
#pragma unroll
      for (int i = 0; i < 16; ++i) {
        const int l = i ^ j;
        if (l > i) {
          const u32 hi = umax(v[i], v[l]), lo = umin(v[i], v[l]);
          if ((i & k) == 0) { v[i] = hi; v[l] = lo; } else { v[i] = lo; v[l] = hi; }
        }
      }
}
DI void merge16_desc(u32 (&a)[16], const u32 (&b)[16]) {
#pragma unroll
  for (int i = 0; i < 16; ++i) a[i] = umax(a[i], b[15 - i]);
#pragma unroll
  for (int j = 8; j > 0; j >>= 1)
#pragma unroll
    for (int i = 0; i < 16; ++i) {
      const int l = i ^ j;
      if (l > i) { const u32 hi = umax(a[i], a[l]), lo = umin(a[i], a[l]); a[i] = hi; a[l] = lo; }
    }
}

DI void peer_route_unit(const Params& p, int tb, int head, char* smem) {
  const int tid = threadIdx.x, lane = tid & 63, w = tid >> 6, wm = w >> 1, wn = w & 1, r = lane & 31, h = lane >> 5;
  const int tok0 = tb * 128;
  u16* sQ = (u16*)smem;
  u32 top[2][16];
#pragma unroll
  for (int half = 0; half < 2; ++half) {
    f32x16 acc[2][2];
#pragma unroll
    for (int a = 0; a < 2; ++a)
#pragma unroll
      for (int b = 0; b < 2; ++b)
#pragma unroll
        for (int i = 0; i < 16; ++i) acc[a][b][i] = 0.f;
    gemm_tile<2, 2, true>(p.x1h + (size_t)tok0 * 1024, 1024, p.w_qT + (size_t)(head * 256 + half * 128) * 1024, 1024, 1024, acc, smem);
    __syncthreads();
#pragma unroll
    for (int a = 0; a < 2; ++a)
#pragma unroll
      for (int b = 0; b < 2; ++b)
#pragma unroll
        for (int i = 0; i < 16; ++i) {
          const int t = wm * 64 + a * 32 + crow(i, h), d = wn * 64 + b * 32 + r;
          sQ[t * 136 + d] = (u16)(pack_h2(acc[a][b][i], 0.f) & 0xffff);
        }
    __syncthreads();
    f32x16 sc[4];
#pragma unroll
    for (int mt = 0; mt < 4; ++mt)
#pragma unroll
      for (int i = 0; i < 16; ++i) sc[mt][i] = 0.f;
    const u16* kbase = p.keysh + (size_t)half * 131072 + (size_t)head * 16384;
#pragma unroll 2
    for (int ks = 0; ks < 8; ++ks) {
      const u32x4 bq = *(const u32x4*)(sQ + (w * 32 + r) * 136 + ks * 16 + 8 * h);
#pragma unroll
      for (int mt = 0; mt < 4; ++mt) {
        const u32x4 ak = *(const u32x4*)(kbase + (mt * 32 + r) * 128 + ks * 16 + 8 * h);
        sc[mt] = mfma32<true>(ak, bq, sc[mt]);
      }
    }
    u32 kv[4][16];
#pragma unroll
    for (int mt = 0; mt < 4; ++mt) {
#pragma unroll
      for (int i = 0; i < 16; ++i) {
        const int key = mt * 32 + crow(i, h);
        kv[mt][i] = (f2key(sc[mt][i]) & ~127u) | (u32)(127 - key);
      }
      sort16_desc(kv[mt]);
    }
    merge16_desc(kv[0], kv[1]);
    merge16_desc(kv[2], kv[3]);
    merge16_desc(kv[0], kv[2]);
    u32 other[16];
#pragma unroll
    for (int i = 0; i < 16; ++i) other[i] = (u32)__shfl_xor((int)kv[0][i], 32);
    merge16_desc(kv[0], other);
#pragma unroll
    for (int i = 0; i < 16; ++i) top[half][i] = kv[0][i];
  }
  __syncthreads();
  int* sIdx = (int*)smem;
  float va[16], vb[16];
#pragma unroll
  for (int i = 0; i < 16; ++i) {
    va[i] = key2f(top[0][i] & ~127u); vb[i] = key2f(top[1][i] & ~127u);
    sIdx[tid * 33 + i] = 127 - (int)(top[0][i] & 127u);
    sIdx[tid * 33 + 16 + i] = 127 - (int)(top[1][i] & 127u);
  }
  u32 cd[4][16];
  {
    u32 c[64];
    int n = 0;
#pragma unroll
    for (int i = 0; i < 16; ++i)
#pragma unroll
      for (int j = 0; j < 16; ++j)
        if ((i + 1) * (j + 1) <= 16) { c[n] = (f2key(va[i] + vb[j]) & ~255u) | (u32)(255 - (i * 16 + j)); ++n; }
#pragma unroll
    for (int q = 50; q < 64; ++q) c[q] = 0u;
#pragma unroll
    for (int g = 0; g < 4; ++g)
#pragma unroll
      for (int i = 0; i < 16; ++i) cd[g][i] = c[g * 16 + i];
  }
#pragma unroll
  for (int g = 0; g < 4; ++g) sort16_desc(cd[g]);
  merge16_desc(cd[0], cd[1]);
  merge16_desc(cd[2], cd[3]);
  merge16_desc(cd[0], cd[2]);
  float sv[16], sum = 0.f;
  const float mx = key2f(cd[0][0] & ~255u);
#pragma unroll
  for (int i = 0; i < 16; ++i) { sv[i] = __expf(key2f(cd[0][i] & ~255u) - mx); sum += sv[i]; }
  const float inv = 1.f / sum;
  if (h == 0) {
    const size_t o = (size_t)(tok0 + w * 32 + r) * 128 + head * 16;
#pragma unroll
    for (int q = 0; q < 4; ++q) {
      int e[4]; f32x4 g;
#pragma unroll
      for (int c = 0; c < 4; ++c) {
        const int code = 255 - (int)(cd[0][q * 4 + c] & 255u);
        const int ea = sIdx[tid * 33 + (code >> 4)], eb = sIdx[tid * 33 + 16 + (code & 15)];
        e[c] = ea * 128 + eb;
        g[c] = sv[q * 4 + c] * inv;
      }
      *(u32x4*)(p.eid + o + q * 4) = (u32x4){(u32)e[0], (u32)e[1], (u32)e[2], (u32)e[3]};
      *(f32x4*)(p.gate + o + q * 4) = g;
    }
  }
  __syncthreads();
}

DI void phase4(const Params& p, char* smem) {
  for (int u = blockIdx.x; u < 1024; u += gridDim.x) peer_route_unit(p, u >> 3, u & 7, smem);
}

DI float wave_sum(float v) {
#pragma unroll
  for (int o = 32; o > 0; o >>= 1) v += __shfl_xor(v, o);
  return v;
}

DI void phase5(const Params& p) {
  const int lane = threadIdx.x & 63;
  const int gw = blockIdx.x * 4 + (threadIdx.x >> 6), nw = gridDim.x * 4;
  for (int tok = gw; tok < T_TOK; tok += nw) {
    const u32x4* xr = (const u32x4*)(p.x1h + (size_t)tok * 1024);
    const h8_t xah = __builtin_bit_cast(h8_t, xr[lane]), xbh = __builtin_bit_cast(h8_t, xr[64 + lane]);
    const int e0 = p.eid[(size_t)tok * 128 + lane], e1 = p.eid[(size_t)tok * 128 + 64 + lane];
    const float g0 = p.gate[(size_t)tok * 128 + lane], g1 = p.gate[(size_t)tok * 128 + 64 + lane];
    float acc[16];
#pragma unroll
    for (int i = 0; i < 16; ++i) acc[i] = 0.f;
#pragma unroll 1
    for (int kk = 0; kk < 128; kk += 4) {
      u32x4 ua[4], ub[4], va[4], vb[4];
      float gg[4];
      const int esel = (kk < 64) ? e0 : e1;
      const int gsel = __float_as_int((kk < 64) ? g0 : g1);
#pragma unroll
      for (int u = 0; u < 4; ++u) {
        const int k = (kk & 63) + u;
        const int e = __builtin_amdgcn_readlane(esel, k);
        gg[u] = __int_as_float(__builtin_amdgcn_readlane(gsel, k));
        const u32x4* ur = (const u32x4*)(p.u16t + (size_t)e * 1024);
        const u32x4* vr = (const u32x4*)(p.v16t + (size_t)e * 1024);
        ua[u] = ur[lane]; ub[u] = ur[64 + lane]; va[u] = vr[lane]; vb[u] = vr[64 + lane];
      }
#pragma unroll
      for (int u = 0; u < 4; ++u) {
        float d = 0.f;
        {
          const h8_t uah = __builtin_bit_cast(h8_t, ua[u]), ubh = __builtin_bit_cast(h8_t, ub[u]);
#pragma unroll
          for (int j = 0; j < 4; ++j) {
            const h2_t a = {uah[2 * j], uah[2 * j + 1]}, xa2 = {xah[2 * j], xah[2 * j + 1]};
            const h2_t b = {ubh[2 * j], ubh[2 * j + 1]}, xb2 = {xbh[2 * j], xbh[2 * j + 1]};
            d = __builtin_amdgcn_fdot2(a, xa2, d, false);
            d = __builtin_amdgcn_fdot2(b, xb2, d, false);
          }
        }
        d = wave_sum(d);
        const float wgt = gg[u] * gelu_f(d);
        {
          const h8_t vah = __builtin_bit_cast(h8_t, va[u]), vbh = __builtin_bit_cast(h8_t, vb[u]);
#pragma unroll
          for (int j = 0; j < 8; ++j) { acc[j] += wgt * (float)vah[j]; acc[8 + j] += wgt * (float)vbh[j]; }
        }
      }
    }
    const float* x1r = p.x1f + (size_t)tok * 1024;
    float y[16];
    float s = 0.f;
#pragma unroll
    for (int q = 0; q < 4; ++q) {
      const int col = (q >> 1) * 512 + lane * 8 + (q & 1) * 4;
      const f32x4 xv = *(const f32x4*)(x1r + col);
#pragma unroll
      for (int c = 0; c < 4; ++c) { y[q * 4 + c] = ALPHA * xv[c] + acc[q * 4 + c]; s += y[q * 4 + c]; }
    }
    s = wave_sum(s);
    const float mu = s * (1.f / 1024.f);
    float qv = 0.f;
#pragma unroll
    for (int i = 0; i < 16; ++i) { const float d = y[i] - mu; qv += d * d; }
    qv = wave_sum(qv);
    const float rs = rsqrtf(qv * (1.f / 1024.f) + LN_EPS);
#pragma unroll
    for (int q = 0; q < 4; ++q) {
      const int col = (q >> 1) * 512 + lane * 8 + (q & 1) * 4;
      const f32x4 g = *(const f32x4*)(p.ln2g + col), be = *(const f32x4*)(p.ln2b + col);
      f32x4 o;
#pragma unroll
      for (int c = 0; c < 4; ++c) o[c] = (y[q * 4 + c] - mu) * rs * g[c] + be[c];
      *(f32x4*)(p.out + (size_t)tok * 1024 + col) = o;
    }
  }
}

__global__ void __launch_bounds__(256, 2) mega(Params p, int lo, int hi) {
  __shared__ __attribute__((aligned(16))) char smem[55296];
  cg::grid_group grid = cg::this_grid();
#ifndef ONLY_PHASE
#define ONLY_PHASE -1
#endif
#define RUNPH(n) (lo <= n && n < hi && (ONLY_PHASE < 0 || ONLY_PHASE == n))
#define SYNCPH(n) if (lo <= n && n + 1 < hi) grid.sync();
  if (RUNPH(0)) phase0(p, smem);
  SYNCPH(0)
  if (RUNPH(1)) phase1(p, smem);
  SYNCPH(1)
  if (RUNPH(2)) phase2(p, smem);
  SYNCPH(2)
  if (RUNPH(3)) phase3(p, smem);
  SYNCPH(3)
  if (RUNPH(4)) phase4(p, smem);
  SYNCPH(4)
  if (RUNPH(5)) phase5(p);
}

extern "C" void kernel_launch(void* const* d_in, const int* in_sizes, int n_in, void* d_out, int out_size, void* d_ws,
                              size_t ws_size, hipStream_t stream) {
  Params p{};
  const float** f = (const float**)&p;
  for (int i = 0; i < 21; ++i) f[i] = (const float*)d_in[i];
  p.out = (float*)d_out;
  char* ws = (char*)d_ws;
  size_t off = 0;
  auto take = [&](size_t bytes) { char* r = ws + off; off += (bytes + 255) & ~(size_t)255; return r; };
  const size_t MB = 1u << 20;
  p.xb = (u16*)take(32 * MB); p.mixcat = p.xb;
  p.u16t = (u16*)take(32 * MB);
  p.v16t = (u16*)take(32 * MB);
  char* R = take(80 * MB);
  p.zu = (u16*)R; p.zvT = (u16*)(R + 16 * MB); p.qb = (u16*)(R + 32 * MB); p.kb = (u16*)(R + 48 * MB); p.vT = (u16*)(R + 64 * MB);
  p.x1f = (float*)R;
  p.x1h = (u16*)take(32 * MB);
  p.eid = (int*)take(8 * MB);
  p.gate = (float*)take(8 * MB);
  p.w_inT = (u16*)take(5 * MB);
  p.w_oT = (u16*)take(2 * MB);
  p.w_qT = (u16*)take(4 * MB);
  p.keysh = (u16*)take(512 * 1024);
  p.wsb = (u16*)take(128 * 1024);
  if (off > ws_size) { fprintf(stderr, "workspace too small: need %zu have %zu\n", off, ws_size); return; }
  static int grid_blocks = 0;
  if (!grid_blocks) {
    int dev = 0, cus = 0, per_cu = 0;
    hipGetDevice(&dev);
    hipDeviceGetAttribute(&cus, hipDeviceAttributeMultiprocessorCount, dev);
    hipOccupancyMaxActiveBlocksPerMultiprocessor(&per_cu, mega, 256, 0);
    if (per_cu > 2) per_cu = 2;
    grid_blocks = cus * per_cu;
  }
#ifdef MULTI_LAUNCH
  for (int ph = 0; ph < 6; ++ph) hipLaunchKernelGGL(mega, dim3(grid_blocks), dim3(256), 0, stream, p, ph, ph + 1);
#else
  int lo = 0, hi = 6;
  void* args[] = {&p, &lo, &hi};
  hipError_t e = hipLaunchCooperativeKernel((void*)mega, dim3(grid_blocks), dim3(256), args, 0, stream);
  if (e != hipSuccess) fprintf(stderr, "cooperative launch failed: %s (grid %d)\n", hipGetErrorString(e), grid_blocks);
#endif
}
```

```cpp
#include <hip/hip_runtime.h>
#include <hip/hip_cooperative_groups.h>
#include <cstdio>
namespace cg = cooperative_groups;

#define DI __device__ __forceinline__
typedef unsigned short u16;
typedef unsigned int u32;
typedef __attribute__((ext_vector_type(2))) __bf16 bf2_t;
typedef __attribute__((ext_vector_type(2))) float f2_t;
typedef __attribute__((ext_vector_type(2))) _Float16 h2_t;
typedef __attribute__((ext_vector_type(8))) _Float16 h8_t;
typedef __attribute__((ext_vector_type(8))) short s8_t;
typedef __attribute__((ext_vector_type(16))) float f32x16;
typedef __attribute__((ext_vector_type(4))) u32 u32x4;
typedef __attribute__((ext_vector_type(2))) u32 u32x2;
typedef __attribute__((ext_vector_type(4))) float f32x4;

constexpr int T_TOK = 16384;
constexpr int SEQ = 8192;
constexpr float ALPHA = 1.189207115002721f;
constexpr float LN_EPS = 1e-5f;
constexpr float LOG2E = 1.4426950408889634f;
#define LOG2E_C 1.4426950408889634f

struct Params {
  const float *x, *w_in, *gm_g, *gm_b, *gm_ws, *gm_bs, *lq1, *lk1, *lq2, *lk2, *da_g, *w_o, *ln1g, *ln1b,
      *w_q, *keys_a, *keys_b, *pu, *pv, *ln2g, *ln2b;
  float* out;
  u16 *xb, *mixcat, *u16t, *v16t, *zu, *zvT, *qb, *kb, *vT, *x1h, *w_inT, *w_oT, *w_qT, *keysh, *wsb;
  float* x1f;
  int* eid;
  float* gate;
  float* y1;
  unsigned* bar;
  float* lnst;
  char* part;
  unsigned* stats;
};

DI u32 pack_bf2(float a, float b) { f2_t v = {a, b}; bf2_t r = __builtin_convertvector(v, bf2_t); return __builtin_bit_cast(u32, r); }
DI u32 pack_h2(float a, float b) { f2_t v = {a, b}; h2_t r = __builtin_convertvector(v, h2_t); return __builtin_bit_cast(u32, r); }
DI float bf_lo(u32 u) { return __uint_as_float(u << 16); }
DI float bf_hi(u32 u) { return __uint_as_float(u & 0xffff0000u); }
DI float bf2f(u16 u) { return __uint_as_float(((u32)u) << 16); }
DI float gelu_f(float x) { return 0.5f * x * (1.f + erff(x * 0.70710678118654752f)); }
DI float gelu_fast(float x) {
  const float z = fabsf(x) * 0.70710678118654752f;
  const float t = __builtin_amdgcn_rcpf(1.f + 0.3275911f * z);
  const float poly = t * (0.254829592f + t * (-0.284496736f + t * (1.421413741f + t * (-1.453152027f + t * 1.061405429f))));
  const float e = poly * __builtin_amdgcn_exp2f(-z * z * LOG2E_C);
  const float erfabs = 1.f - e;
  const float erfv = x < 0.f ? -erfabs : erfabs;
  return 0.5f * x * (1.f + erfv);
}
DI float wave_sum(float v) {
#pragma unroll
  for (int o = 32; o > 0; o >>= 1) v += __shfl_xor(v, o);
  return v;
}
DI int ltid() { int t = threadIdx.x; asm volatile("" : "+v"(t)); return t; }
DI int crow(int i, int h) { return (i & 3) + 8 * (i >> 2) + 4 * h; }

template <bool F16>
DI f32x16 mfma32(u32x4 a, u32x4 b, f32x16 c) {
  if constexpr (F16)
    return __builtin_amdgcn_mfma_f32_32x32x16_f16(__builtin_bit_cast(h8_t, a), __builtin_bit_cast(h8_t, b), c, 0, 0, 0);
  else
    return __builtin_amdgcn_mfma_f32_32x32x16_bf16(__builtin_bit_cast(s8_t, a), __builtin_bit_cast(s8_t, b), c, 0, 0, 0);
}

template <int TM, int TN, bool F16>
DI void gemm_tile(const u16* __restrict__ A, int lda, const u16* __restrict__ B, int ldb, int K,
                  f32x16 (&acc)[TM][TN], char* smem) {
  static_assert(TM == 2 && TN == 2, "128x128 tile only");
  const int tid = ltid(), lane = tid & 63, w = tid >> 6, wm = w >> 1, wn = w & 1, r = lane & 31, h = lane >> 5;
  typedef __attribute__((address_space(1))) void gvoid;
  typedef __attribute__((address_space(3))) void lvoid;
  const u16* asrc[4];
  const u16* bsrc[4];
#pragma unroll
  for (int j = 0; j < 4; ++j) {
    const int row = (w * 4 + j) * 8 + (lane >> 3);
    const int c = (lane & 7) ^ ((row >> 1) & 7);
    asrc[j] = A + (size_t)row * lda + c * 8;
    bsrc[j] = B + (size_t)row * ldb + c * 8;
  }
  __syncthreads();
#pragma unroll
  for (int j = 0; j < 4; ++j) {
    __builtin_amdgcn_global_load_lds((const gvoid*)asrc[j], (lvoid*)(smem + (w * 4 + j) * 1024), 16, 0, 0);
    __builtin_amdgcn_global_load_lds((const gvoid*)bsrc[j], (lvoid*)(smem + 16384 + (w * 4 + j) * 1024), 16, 0, 0);
  }
  asm volatile("s_waitcnt vmcnt(0)" ::: "memory");
  __syncthreads();
  const int swz = (r >> 1) & 7;
  for (int k0 = 0; k0 < K; k0 += 64) {
    const char* buf = smem + ((k0 >> 6) & 1) * 32768;
    if (k0 + 64 < K) {
      char* nb = smem + (((k0 >> 6) + 1) & 1) * 32768;
#pragma unroll
      for (int j = 0; j < 4; ++j) {
        __builtin_amdgcn_global_load_lds((const gvoid*)(asrc[j] + k0 + 64), (lvoid*)(nb + (w * 4 + j) * 1024), 16, 0, 0);
        __builtin_amdgcn_global_load_lds((const gvoid*)(bsrc[j] + k0 + 64), (lvoid*)(nb + 16384 + (w * 4 + j) * 1024), 16, 0, 0);
      }
    }
#pragma unroll
    for (int ks = 0; ks < 4; ++ks) {
      u32x4 af[2], bfr[2];
      const int co = ((ks * 2 + h) ^ swz) << 4;
#pragma unroll
      for (int mt = 0; mt < 2; ++mt) af[mt] = *(const u32x4*)(buf + (wm * 64 + mt * 32 + r) * 128 + co);
#pragma unroll
      for (int nt = 0; nt < 2; ++nt) bfr[nt] = *(const u32x4*)(buf + 16384 + (wn * 64 + nt * 32 + r) * 128 + co);
#pragma unroll
      for (int mt = 0; mt < 2; ++mt)
#pragma unroll
        for (int nt = 0; nt < 2; ++nt) acc[mt][nt] = mfma32<F16>(af[mt], bfr[nt], acc[mt][nt]);
    }
    asm volatile("s_waitcnt vmcnt(0)" ::: "memory");
    __syncthreads();
  }
}

template <bool F16>
DI void gemm_tile_n4(const u16* __restrict__ A, int lda, const u16* __restrict__ B, int ldb, int K, f32x16 (&acc)[4], char* smem) {
  const int tid = ltid(), lane = tid & 63, w = tid >> 6, r = lane & 31, h = lane >> 5;
  typedef __attribute__((address_space(1))) void gvoid;
  typedef __attribute__((address_space(3))) void lvoid;
  const u16* asrc[4];
  const u16* bsrc[4];
#pragma unroll
  for (int j = 0; j < 4; ++j) {
    const int row = (w * 4 + j) * 8 + (lane >> 3);
    const int c = (lane & 7) ^ ((row >> 1) & 7);
    asrc[j] = A + (size_t)row * lda + c * 8;
    bsrc[j] = B + (size_t)row * ldb + c * 8;
  }
  __syncthreads();
#pragma unroll
  for (int j = 0; j < 4; ++j) {
    __builtin_amdgcn_global_load_lds((const gvoid*)asrc[j], (lvoid*)(smem + (w * 4 + j) * 1024), 16, 0, 0);
    __builtin_amdgcn_global_load_lds((const gvoid*)bsrc[j], (lvoid*)(smem + 16384 + (w * 4 + j) * 1024), 16, 0, 0);
  }
  asm volatile("s_waitcnt vmcnt(0)" ::: "memory");
  __syncthreads();
  const int swz = (r >> 1) & 7;
  for (int k0 = 0; k0 < K; k0 += 64) {
    const char* buf = smem + ((k0 >> 6) & 1) * 32768;
    if (k0 + 64 < K) {
      char* nb = smem + (((k0 >> 6) + 1) & 1) * 32768;
#pragma unroll
      for (int j = 0; j < 4; ++j) {
        __builtin_amdgcn_global_load_lds((const gvoid*)(asrc[j] + k0 + 64), (lvoid*)(nb + (w * 4 + j) * 1024), 16, 0, 0);
        __builtin_amdgcn_global_load_lds((const gvoid*)(bsrc[j] + k0 + 64), (lvoid*)(nb + 16384 + (w * 4 + j) * 1024), 16, 0, 0);
      }
    }
#pragma unroll
    for (int ks = 0; ks < 4; ++ks) {
      const int co = ((ks * 2 + h) ^ swz) << 4;
      const u32x4 bfr = *(const u32x4*)(buf + 16384 + (w * 32 + r) * 128 + co);
      u32x4 af[4];
#pragma unroll
      for (int mt = 0; mt < 4; ++mt) af[mt] = *(const u32x4*)(buf + (mt * 32 + r) * 128 + co);
#pragma unroll
      for (int mt = 0; mt < 4; ++mt) acc[mt] = mfma32<F16>(af[mt], bfr, acc[mt]);
    }
    asm volatile("s_waitcnt vmcnt(0)" ::: "memory");
    __syncthreads();
  }
}

DI void wk_tile(const Params& p, int hh16, int nt, char* smem) {
  const int tid = threadIdx.x, lane = tid & 63, w = tid >> 6, wm = w >> 1, wn = w & 1, r = lane & 31, h = lane >> 5;
  u16* sA = (u16*)smem;
  u16* sB = sA + 128 * 72;
  const float* ksrc = ((hh16 & 1) ? p.keys_b : p.keys_a) + (size_t)(hh16 >> 1) * 16384;
  const float* wsrc = p.w_q + (size_t)(nt * 128) * 2048 + hh16 * 128;
  f32x16 acc[2][2];
#pragma unroll
  for (int a = 0; a < 2; ++a)
#pragma unroll
    for (int b = 0; b < 2; ++b)
#pragma unroll
      for (int i = 0; i < 16; ++i) acc[a][b][i] = 0.f;
  for (int dh = 0; dh < 2; ++dh) {
    __syncthreads();
#pragma unroll
    for (int i = 0; i < 8; ++i) {
      const int idx = tid + 256 * i, row = idx >> 4, c4 = (idx & 15) * 4;
      const f32x4 kv = *(const f32x4*)(ksrc + row * 128 + dh * 64 + c4);
      const f32x4 wv = *(const f32x4*)(wsrc + (size_t)row * 2048 + dh * 64 + c4);
      *(u32x2*)(sA + row * 72 + c4) = (u32x2){pack_h2(kv[0], kv[1]), pack_h2(kv[2], kv[3])};
      *(u32x2*)(sB + row * 72 + c4) = (u32x2){pack_h2(wv[0], wv[1]), pack_h2(wv[2], wv[3])};
    }
    __syncthreads();
#pragma unroll
    for (int ks = 0; ks < 4; ++ks) {
      u32x4 af[2], bfr[2];
#pragma unroll
      for (int mt = 0; mt < 2; ++mt) af[mt] = *(const u32x4*)(sA + (wm * 64 + mt * 32 + r) * 72 + ks * 16 + 8 * h);
#pragma unroll
      for (int nt2 = 0; nt2 < 2; ++nt2) bfr[nt2] = *(const u32x4*)(sB + (wn * 64 + nt2 * 32 + r) * 72 + ks * 16 + 8 * h);
#pragma unroll
      for (int mt = 0; mt < 2; ++mt)
#pragma unroll
        for (int nt2 = 0; nt2 < 2; ++nt2) acc[mt][nt2] = mfma32<true>(af[mt], bfr[nt2], acc[mt][nt2]);
    }
  }
  u16* dst = p.w_qT + (size_t)hh16 * 128 * 1024 + nt * 128;
#pragma unroll
  for (int a = 0; a < 2; ++a)
#pragma unroll
    for (int b = 0; b < 2; ++b)
#pragma unroll
      for (int i = 0; i < 16; ++i)
        dst[(size_t)(wm * 64 + a * 32 + crow(i, h)) * 1024 + wn * 64 + b * 32 + r] = (u16)(pack_h2(acc[a][b][i], 0.f) & 0xffff);
}

template <bool F16>
DI void cvt8(const float* __restrict__ src, u16* __restrict__ dst, size_t i8) {
  const f32x4 a = *(const f32x4*)(src + i8 * 8), b = *(const f32x4*)(src + i8 * 8 + 4);
  u32x4 o;
  if constexpr (F16) { o[0] = pack_h2(a[0], a[1]); o[1] = pack_h2(a[2], a[3]); o[2] = pack_h2(b[0], b[1]); o[3] = pack_h2(b[2], b[3]); }
  else { o[0] = pack_bf2(a[0], a[1]); o[1] = pack_bf2(a[2], a[3]); o[2] = pack_bf2(b[0], b[1]); o[3] = pack_bf2(b[2], b[3]); }
  *(u32x4*)(dst + i8 * 8) = o;
}

DI void cvt8_fp8(const float* __restrict__ src, unsigned char* __restrict__ dst, size_t i8, float sc) {
  const f32x4 a = *(const f32x4*)(src + i8 * 8), b = *(const f32x4*)(src + i8 * 8 + 4);
  int w0 = 0, w1 = 0;
  w0 = __builtin_amdgcn_cvt_pk_fp8_f32(a[0] * sc, a[1] * sc, w0, false);
  w0 = __builtin_amdgcn_cvt_pk_fp8_f32(a[2] * sc, a[3] * sc, w0, true);
  w1 = __builtin_amdgcn_cvt_pk_fp8_f32(b[0] * sc, b[1] * sc, w1, false);
  w1 = __builtin_amdgcn_cvt_pk_fp8_f32(b[2] * sc, b[3] * sc, w1, true);
  *(u32x2*)(dst + i8 * 8) = (u32x2){(u32)w0, (u32)w1};
}

template <bool F16>
DI void transpose_tile(const float* __restrict__ W, int N, u16* __restrict__ WT, int kt, int nt, char* smem) {
  float* sT = (float*)smem;
  const int tid = threadIdx.x;
  __syncthreads();
#pragma unroll
  for (int i = 0; i < 4; ++i) {
    const int row = (tid >> 4) + 16 * i, c4 = (tid & 15) * 4;
    const f32x4 v = *(const f32x4*)(W + (size_t)(kt * 64 + row) * N + nt * 64 + c4);
    sT[row * 65 + c4 + 0] = v[0]; sT[row * 65 + c4 + 1] = v[1]; sT[row * 65 + c4 + 2] = v[2]; sT[row * 65 + c4 + 3] = v[3];
  }
  __syncthreads();
  const int n = tid >> 2, ks = (tid & 3) * 16;
  u32 o[8];
#pragma unroll
  for (int j = 0; j < 8; ++j) {
    const float a = sT[(ks + 2 * j) * 65 + n], b = sT[(ks + 2 * j + 1) * 65 + n];
    o[j] = F16 ? pack_h2(a, b) : pack_bf2(a, b);
  }
  u16* d = WT + (size_t)(nt * 64 + n) * 1024 + kt * 64 + ks;
  *(u32x4*)d = (u32x4){o[0], o[1], o[2], o[3]};
  *(u32x4*)(d + 8) = (u32x4){o[4], o[5], o[6], o[7]};
}

DI void phase0(const Params& p, char* smem) {
  const size_t gt = (size_t)blockIdx.x * 256 + threadIdx.x, gs = (size_t)gridDim.x * 256;
  for (size_t i = gt; i < (size_t)T_TOK * 1024 / 8; i += gs) cvt8<false>(p.x, p.xb, i);
  for (size_t i = gt; i < (size_t)T_TOK * 2; i += gs) p.lnst[i] = 0.f;
  for (size_t i = gt; i < 131072 / 8; i += gs) { cvt8<true>(p.keys_a, p.keysh, i); cvt8<true>(p.keys_b, p.keysh + 131072, i); }
  for (size_t i = gt; i < 65536; i += gs) {
    const int t = (i >> 7) & 127, s = i & 127;
    p.wsb[i] = (u16)(pack_bf2(s <= t ? p.gm_ws[i] : 0.f, 0.f) & 0xffff);
  }
  for (int t = blockIdx.x; t < 640 + 256 + 128; t += gridDim.x) {
    if (t < 640) transpose_tile<false>(p.w_in, 2560, p.w_inT, t / 40, t % 40, smem);
    else if (t < 896) transpose_tile<false>(p.w_o, 1024, p.w_oT, (t - 640) / 16, (t - 640) % 16, smem);
    else wk_tile(p, (t - 896) >> 3, (t - 896) & 7, smem);
  }
}

DI void phase1(const Params& p, char* smem) {
  const int lane = threadIdx.x & 63, w = threadIdx.x >> 6, wm = w >> 1, wn = w & 1, r = lane & 31, h = lane >> 5;
  for (int t = blockIdx.x; t < 128 * 20; t += gridDim.x) {
    const int mt_ = t / 20, nt_ = t % 20;
    const int m0 = mt_ * 128, n0 = nt_ * 128;
    const bool swapped = (n0 >= 512 && n0 < 1024) || (n0 >= 2048);
    f32x16 acc[2][2];
#pragma unroll
    for (int a = 0; a < 2; ++a)
#pragma unroll
      for (int b = 0; b < 2; ++b)
#pragma unroll
        for (int i = 0; i < 16; ++i) acc[a][b][i] = 0.f;
    if (!swapped) {
      gemm_tile<2, 2, false>(p.xb + (size_t)m0 * 1024, 1024, p.w_inT + (size_t)n0 * 1024, 1024, 1024, acc, smem);
      u16* dst; int cb; int mode;
      if (n0 < 512) { dst = p.zu; cb = n0; mode = 0; }
      else if (n0 < 1536) { dst = p.qb; cb = n0 - 1024; mode = 1; }
      else { dst = p.kb; cb = n0 - 1536; mode = 2; }
      float nmax = 0.f;
      u16* sC = (u16*)smem;
      __syncthreads();
#pragma unroll
      for (int a = 0; a < 2; ++a)
#pragma unroll
        for (int i = 0; i < 16; ++i) {
          float sq = 0.f;
#pragma unroll
          for (int b = 0; b < 2; ++b) {
            float v = acc[a][b][i];
            if (mode == 0) v = gelu_fast(v);
            else if (mode == 1) v *= 0.125f * LOG2E;
            const u32 pk = pack_bf2(v, 0.f);
            const float vr = bf_lo(pk);
            sq += vr * vr;
            sC[(wm * 64 + a * 32 + crow(i, h)) * 136 + wn * 64 + b * 32 + r] = (u16)(pk & 0xffff);
          }
          if (mode != 0) {
#pragma unroll
            for (int o = 1; o < 32; o <<= 1) sq += __shfl_xor(sq, o);
            nmax = fmaxf(nmax, sq);
          }
        }
      if (mode != 0) {
        nmax = fmaxf(nmax, __shfl_xor(nmax, 32));
        if (lane == 0) atomicMax(p.stats + (mode == 2 ? 16 : 0) + ((m0 >> 13) * 4 + (cb >> 7)) * 2 + wn, __float_as_uint(nmax));
      }
      __syncthreads();
#pragma unroll
      for (int i = 0; i < 8; ++i) {
        const int idx = threadIdx.x + 256 * i, t = idx >> 4, c = idx & 15;
        *(u32x4*)(dst + (size_t)(m0 + t) * 512 + cb + c * 8) = *(const u32x4*)(sC + t * 136 + c * 8);
      }
    } else {
      gemm_tile<2, 2, false>(p.w_inT + (size_t)n0 * 1024, 1024, p.xb + (size_t)m0 * 1024, 1024, 1024, acc, smem);
      const bool isz = n0 < 1024;
      u16* dst = isz ? p.zvT : p.vT;
      const int cb = isz ? n0 - 512 : n0 - 2048;
      const int bb = m0 >> 13, s0 = m0 & 8191;
      u16* sC = (u16*)smem;
      __syncthreads();
#pragma unroll
      for (int a = 0; a < 2; ++a)
#pragma unroll
        for (int b = 0; b < 2; ++b)
#pragma unroll
          for (int i = 0; i < 16; ++i) {
            float v = acc[a][b][i];
            if (isz) v = gelu_fast(v);
            const u32 pk = pack_bf2(v, 0.f);
            acc[a][b][i] = bf_lo(pk);
            sC[(wm * 64 + a * 32 + crow(i, h)) * 136 + wn * 64 + b * 32 + r] = (u16)(pk & 0xffff);
          }
      if (isz) {
#pragma unroll
        for (int b = 0; b < 2; ++b) {
          float sm = 0.f, sq = 0.f;
#pragma unroll
          for (int a = 0; a < 2; ++a)
#pragma unroll
            for (int i = 0; i < 16; ++i) { const float v = acc[a][b][i]; sm += v; sq += v * v; }
          sm += __shfl_xor(sm, 32); sq += __shfl_xor(sq, 32);
          if (h == 0) {
            float* st = p.lnst + (size_t)(m0 + wn * 64 + b * 32 + r) * 2;
            atomicAdd(st, sm); atomicAdd(st + 1, sq);
          }
        }
      }
      __syncthreads();
#pragma unroll
      for (int i = 0; i < 8; ++i) {
        const int idx = threadIdx.x + 256 * i, t = idx >> 4, c = idx & 15;
        *(u32x4*)(dst + ((size_t)bb * 512 + cb + t) * SEQ + s0 + c * 8) = *(const u32x4*)(sC + t * 136 + c * 8);
      }
    }
  }
}

DI void gmlp_unit(const Params& p, int chunk, int hh, char* smem) {
  const int tid = ltid(), lane = tid & 63, w = tid >> 6, wm = w >> 1, wn = w & 1, r = lane & 31, h = lane >> 5;
  const int tok0 = chunk * 128, bb = tok0 >> 13, s0 = tok0 & 8191;
  float* sMu = (float*)smem;
  float* sRs = sMu + 128;
  float* sPart = sRs + 128;
  u16* sA = (u16*)(smem + 17408);
  u16* sB = sA + 128 * 72;
  __syncthreads();
  if (tid < 128) {
    const float sa = p.lnst[(size_t)(tok0 + tid) * 2], sb = p.lnst[(size_t)(tok0 + tid) * 2 + 1];
    const float mu = sa * (1.f / 512.f);
    const float var = fmaxf(sb * (1.f / 512.f) - mu * mu, 0.f);
    sMu[tid] = mu; sRs[tid] = rsqrtf(var + LN_EPS);
  }
  f32x16 acc[2][2];
#pragma unroll
  for (int a = 0; a < 2; ++a)
#pragma unroll
    for (int b = 0; b < 2; ++b)
#pragma unroll
      for (int i = 0; i < 16; ++i) acc[a][b][i] = 0.f;
  for (int kh = 0; kh < 2; ++kh) {
    __syncthreads();
#pragma unroll
    for (int i = 0; i < 4; ++i) {
      const int idx = tid + 256 * i, row = idx >> 3, c = idx & 7;
      *(u32x4*)(sA + row * 72 + c * 8) = *(const u32x4*)(p.wsb + (size_t)hh * 16384 + row * 128 + kh * 64 + c * 8);
      const int ch = hh * 128 + row;
      const u32x4 v = *(const u32x4*)(p.zvT + ((size_t)bb * 512 + ch) * SEQ + s0 + kh * 64 + c * 8);
      const float g = p.gm_g[ch], be = p.gm_b[ch];
      u32x4 o;
#pragma unroll
      for (int j = 0; j < 4; ++j) {
        const int s = kh * 64 + c * 8 + 2 * j;
        const float a = (bf_lo(v[j]) - sMu[s]) * sRs[s] * g + be;
        const float b = (bf_hi(v[j]) - sMu[s + 1]) * sRs[s + 1] * g + be;
        o[j] = pack_bf2(a, b);
      }
      *(u32x4*)(sB + row * 72 + c * 8) = o;
    }
    __syncthreads();
#pragma unroll
    for (int ks = 0; ks < 4; ++ks) {
      u32x4 af[2], bfr[2];
#pragma unroll
      for (int mt = 0; mt < 2; ++mt) af[mt] = *(const u32x4*)(sA + (wm * 64 + mt * 32 + r) * 72 + ks * 16 + 8 * h);
#pragma unroll
      for (int nt = 0; nt < 2; ++nt) bfr[nt] = *(const u32x4*)(sB + (wn * 64 + nt * 32 + r) * 72 + ks * 16 + 8 * h);
#pragma unroll
      for (int mt = 0; mt < 2; ++mt)
#pragma unroll
        for (int nt = 0; nt < 2; ++nt) acc[mt][nt] = mfma32<false>(af[mt], bfr[nt], acc[mt][nt]);
    }
  }
  __syncthreads();
  {
    u16* sC = (u16*)smem;
#pragma unroll
    for (int a = 0; a < 2; ++a)
#pragma unroll
      for (int i = 0; i < 16; ++i) {
        const int t = wm * 64 + a * 32 + crow(i, h);
        const float bs = p.gm_bs[hh * 128 + t];
#pragma unroll
        for (int b = 0; b < 2; ++b) sC[t * 136 + wn * 64 + b * 32 + r] = (u16)(pack_bf2(acc[a][b][i] + bs, 0.f) & 0xffff);
      }
    __syncthreads();
#pragma unroll
    for (int i = 0; i < 8; ++i) {
      const int idx = tid + 256 * i, t = idx >> 4, c = idx & 15;
      const u32x4 mv = *(const u32x4*)(sC + t * 136 + c * 8);
      const u32x4 uv = *(const u32x4*)(p.zu + (size_t)(tok0 + t) * 512 + hh * 128 + c * 8);
      u32x4 o;
#pragma unroll
      for (int j = 0; j < 4; ++j) o[j] = pack_bf2(bf_lo(mv[j]) * bf_lo(uv[j]), bf_hi(mv[j]) * bf_hi(uv[j]));
      *(u32x4*)(p.mixcat + (size_t)(tok0 + t) * 1024 + hh * 128 + c * 8) = o;
    }
  }
}

DI void attn_core(const Params& p, int bb, int hh, int qt, int ktb, int kte, char* smem, f32x16 (&O)[4], float& m_out, float& l_out) {
  const int tid = ltid(), lane = tid & 63, w = tid >> 6, r = lane & 31, h = lane >> 5;
  const int map = w >> 1, qs = w & 1;
  const size_t tok0 = (size_t)bb * SEQ;
  const int q0 = qt * 64;
  const float slope2 = exp2f(-2.f * (float)(hh + 1)) * LOG2E;
  u32x4 qf[4];
  {
    const u16* qptr = p.qb + (tok0 + q0 + qs * 32 + r) * 512 + hh * 128 + map * 64 + 8 * h;
#pragma unroll
    for (int ks = 0; ks < 4; ++ks) qf[ks] = *(const u32x4*)(qptr + ks * 16);
  }
#pragma unroll
  for (int d = 0; d < 4; ++d)
#pragma unroll
    for (int i = 0; i < 16; ++i) O[d][i] = 0.f;
  float m = -1e30f, l = 0.f;
  const u16* kbase = p.kb + tok0 * 512 + hh * 128;
  const u16* vbase = p.vT + (size_t)(bb * 4 + hh) * 128 * SEQ;
  u32 koff[4], voff[4];
#pragma unroll
  for (int j = 0; j < 4; ++j) {
    const int krow = (w * 4 + j) * 4 + (lane >> 4);
    koff[j] = (u32)(krow * 512 + (((lane & 15) ^ (krow & 15)) << 3));
    const int vrow = (w * 4 + j) * 8 + (lane >> 3);
    voff[j] = (u32)(vrow * SEQ + (((lane & 7) ^ ((vrow >> 1) & 7)) << 3));
  }
  const int kr = (r & ~12) | ((r & 4) << 1) | ((r & 8) >> 1);
  const float hb = slope2 * (float)(8 * h);
  typedef __attribute__((address_space(1))) void gvoid;
  typedef __attribute__((address_space(3))) void lvoid;
  __syncthreads();
  {
    char* buf = smem + (ktb & 1) * 32768;
#pragma unroll
    for (int j = 0; j < 4; ++j) {
      __builtin_amdgcn_global_load_lds((const gvoid*)(kbase + (size_t)ktb * 64 * 512 + koff[j]), (lvoid*)(buf + (w * 4 + j) * 1024), 16, 0, 0);
      __builtin_amdgcn_global_load_lds((const gvoid*)(vbase + (size_t)ktb * 64 + voff[j]), (lvoid*)(buf + 16384 + (w * 4 + j) * 1024), 16, 0, 0);
    }
  }
  asm volatile("s_waitcnt vmcnt(0)" ::: "memory");
  __syncthreads();
  for (int kt = ktb; kt < kte; ++kt) {
    const char* buf = smem + (kt & 1) * 32768;
    if (kt + 1 < kte) {
      char* nb = smem + ((kt + 1) & 1) * 32768;
#pragma unroll
      for (int j = 0; j < 4; ++j) {
        __builtin_amdgcn_global_load_lds((const gvoid*)(kbase + (size_t)(kt + 1) * 64 * 512 + koff[j]), (lvoid*)(nb + (w * 4 + j) * 1024), 16, 0, 0);
        __builtin_amdgcn_global_load_lds((const gvoid*)(vbase + (size_t)(kt + 1) * 64 + voff[j]), (lvoid*)(nb + 16384 + (w * 4 + j) * 1024), 16, 0, 0);
      }
    }
    f32x16 S[2];
    {
      float hb2 = hb, sl = slope2;
      asm volatile("" : "+v"(hb2), "+v"(sl));
#pragma unroll
      for (int mt = 0; mt < 2; ++mt)
#pragma unroll
        for (int i = 0; i < 16; ++i) {
          if ((i & 7) == 0) S[mt][i] = hb2 + sl * (float)(32 * mt + 16 * (i >> 3));
          else S[mt][i] = S[mt][i - 1] + sl;
        }
    }
#pragma unroll
    for (int mt = 0; mt < 2; ++mt) {
      u32x4 af[4];
#pragma unroll
      for (int ks = 0; ks < 4; ++ks)
        af[ks] = *(const u32x4*)(buf + (mt * 32 + kr) * 256 + (((map * 8 + ks * 2 + h) ^ (kr & 15)) << 4));
#pragma unroll
      for (int ks = 0; ks < 4; ++ks) S[mt] = mfma32<false>(af[ks], qf[ks], S[mt]);
    }
    if (kt > ktb) m -= slope2 * 64.f;
    if (kt == qt) {
      const int qrel = qs * 32 + r;
#pragma unroll
      for (int mt = 0; mt < 2; ++mt)
#pragma unroll
        for (int i = 0; i < 16; ++i) {
          const int keyrel = 32 * mt + 16 * (i >> 3) + 8 * h + (i & 7);
          if (keyrel > qrel) S[mt][i] = -1e30f;
        }
    }
    float mx = S[0][0];
#pragma unroll
    for (int i = 1; i < 16; ++i) mx = fmaxf(mx, S[0][i]);
#pragma unroll
    for (int i = 0; i < 16; ++i) mx = fmaxf(mx, S[1][i]);
    mx = fmaxf(mx, __shfl_xor(mx, 32));
    if (__any(mx > m + 8.f)) {
      const float mn = fmaxf(m, mx);
      const float alpha = __builtin_amdgcn_exp2f(m - mn);
      m = mn;
      l *= alpha;
#pragma unroll
      for (int d = 0; d < 4; ++d)
#pragma unroll
        for (int i = 0; i < 16; ++i) O[d][i] *= alpha;
    }
    float ls = 0.f;
#pragma unroll
    for (int mt = 0; mt < 2; ++mt)
#pragma unroll
      for (int i = 0; i < 16; ++i) { const float e = __builtin_amdgcn_exp2f(S[mt][i] - m); S[mt][i] = e; ls += e; }
    l += ls;
#pragma unroll
    for (int mt = 0; mt < 2; ++mt)
#pragma unroll
      for (int s2 = 0; s2 < 2; ++s2) {
        u32x4 pf;
#pragma unroll
        for (int j = 0; j < 4; ++j) pf[j] = pack_bf2(S[mt][8 * s2 + 2 * j], S[mt][8 * s2 + 2 * j + 1]);
        u32x4 vf[4];
#pragma unroll
        for (int d = 0; d < 4; ++d)
          vf[d] = *(const u32x4*)(buf + 16384 + (d * 32 + r) * 128 + (((mt * 4 + s2 * 2 + h) ^ ((r >> 1) & 7)) << 4));
#pragma unroll
        for (int d = 0; d < 4; ++d) O[d] = mfma32<false>(vf[d], pf, O[d]);
      }
    asm volatile("s_waitcnt vmcnt(0)" ::: "memory");
    __syncthreads();
  }
  m_out = m; l_out = l;
}

DI void attn_finish(const Params& p, int bb, int hh, int qt, float lam, char* smem, f32x16 (&O)[4], float inv) {
  const int tid = ltid(), lane = tid & 63, w = tid >> 6, r = lane & 31, h = lane >> 5;
  const int map = w >> 1, qs = w & 1;
  const size_t tok0 = (size_t)bb * SEQ;
  const int q0 = qt * 64;
  __syncthreads();
  float* sC = (float*)smem;
  if (map == 1) {
    const float sc = inv * lam;
#pragma unroll
    for (int d = 0; d < 4; ++d)
#pragma unroll
      for (int i = 0; i < 16; ++i) sC[(qs * 64 + d * 16 + i) * 64 + lane] = O[d][i] * sc;
  }
  __syncthreads();
  if (map == 0) {
    float ss = 0.f;
#pragma unroll
    for (int d = 0; d < 4; ++d)
#pragma unroll
      for (int i = 0; i < 16; ++i) {
        const float v = O[d][i] * inv - sC[(qs * 64 + d * 16 + i) * 64 + lane];
        O[d][i] = v; ss += v * v;
      }
    ss += __shfl_xor(ss, 32);
    const float rs = rsqrtf(ss * (1.f / 128.f) + LN_EPS) * 0.8f;
    u16* dst = p.mixcat + (tok0 + q0 + qs * 32 + r) * 1024 + 512 + hh * 128;
#pragma unroll
    for (int d = 0; d < 4; ++d)
#pragma unroll
      for (int i4 = 0; i4 < 4; ++i4) {
        const int dv0 = d * 32 + 8 * i4 + 4 * h;
        const f32x4 g = *(const f32x4*)(p.da_g + hh * 128 + dv0);
        u32x2 o;
        o[0] = pack_bf2(O[d][4 * i4] * rs * g[0], O[d][4 * i4 + 1] * rs * g[1]);
        o[1] = pack_bf2(O[d][4 * i4 + 2] * rs * g[2], O[d][4 * i4 + 3] * rs * g[3]);
        *(u32x2*)(dst + dv0) = o;
      }
  }
}

typedef __attribute__((address_space(1))) u32 gu32;
#define RLX_AGENT __ATOMIC_RELAXED, __HIP_MEMORY_SCOPE_AGENT
constexpr size_t ATT_SLOT = 34816;

DI void attn_chunk(const Params& p, int bb, int hh, int qt, int ktb, int kte, int ch, int nch, float lam, char* smem, int* s_flag) {
  const int tid = ltid(), lane = tid & 63, w = tid >> 6;
  f32x16 O[4];
  float m, l;
  attn_core(p, bb, hh, qt, ktb, kte, smem, O, m, l);
  l += __shfl_xor(l, 32);
  if (nch == 1) { attn_finish(p, bb, hh, qt, lam, smem, O, 1.f / l); return; }
  const float slope2 = exp2f(-2.f * (float)(hh + 1)) * LOG2E;
  const int uidx = ((bb * 2 + (hh - 2)) * 128 + qt) * 4;
  {
    char* slot = p.part + (size_t)(uidx + ch) * ATT_SLOT;
    gu32* po = (gu32*)((u32*)slot + (size_t)w * 32 * 64 + lane);
    const float invl = 1.f / l;
#pragma unroll
    for (int d = 0; d < 4; ++d)
#pragma unroll
      for (int k = 0; k < 8; ++k) __hip_atomic_store(po + (d * 8 + k) * 64, pack_h2(O[d][2 * k] * invl, O[d][2 * k + 1] * invl), RLX_AGENT);
    gu32* pm = (gu32*)((u32*)(slot + 32768) + w * 128 + lane);
    __hip_atomic_store(pm, __float_as_uint(m + slope2 * 64.f * (float)(kte - 1)), RLX_AGENT);
    __hip_atomic_store(pm + 64, __float_as_uint(l), RLX_AGENT);
  }
  asm volatile("s_waitcnt vmcnt(0)" ::: "memory");
  __syncthreads();
  if (tid == 0) *s_flag = (int)__hip_atomic_fetch_add(p.stats + 64 + ((bb * 4 + hh) * 128 + qt), 1u, RLX_AGENT);
  __syncthreads();
  if (*s_flag != nch - 1) return;
  float mc[4], lc[4];
  float M = -1e30f;
#pragma unroll
  for (int c = 0; c < 4; ++c) {
    mc[c] = -1e30f; lc[c] = 0.f;
    if (c < nch) {
      gu32* pm = (gu32*)((u32*)(p.part + (size_t)(uidx + c) * ATT_SLOT + 32768) + w * 128 + lane);
      mc[c] = __uint_as_float(__hip_atomic_load(pm, RLX_AGENT)); lc[c] = __uint_as_float(__hip_atomic_load(pm + 64, RLX_AGENT));
      M = fmaxf(M, mc[c]);
    }
  }
#pragma unroll
  for (int d = 0; d < 4; ++d)
#pragma unroll
    for (int i = 0; i < 16; ++i) O[d][i] = 0.f;
  float lsum = 0.f;
#pragma unroll
  for (int c = 0; c < 4; ++c) {
    if (c < nch) {
      const float wc = lc[c] * __builtin_amdgcn_exp2f(mc[c] - M);
      lsum += wc;
      gu32* po = (gu32*)((u32*)(p.part + (size_t)(uidx + c) * ATT_SLOT) + (size_t)w * 32 * 64 + lane);
#pragma unroll
      for (int d = 0; d < 4; ++d)
#pragma unroll
        for (int k = 0; k < 8; ++k) {
          const u32 v = __hip_atomic_load(po + (d * 8 + k) * 64, RLX_AGENT);
          const h2_t hv = __builtin_bit_cast(h2_t, v);
          O[d][2 * k] += wc * (float)hv[0];
          O[d][2 * k + 1] += wc * (float)hv[1];
        }
    }
  }
  attn_finish(p, bb, hh, qt, lam, smem, O, 1.f / lsum);
}

DI void phase2(const Params& p, char* smem) {
  __shared__ int s_unit;
  __shared__ int s_flag;
  float lam;
  {
    float a = 0.f, b = 0.f;
    for (int i = 0; i < 64; ++i) { a += p.lq1[i] * p.lk1[i]; b += p.lq2[i] * p.lk2[i]; }
    lam = expf(a) - expf(b) + 0.2f;
  }
  for (;;) {
    __syncthreads();
    if (threadIdx.x == 0) s_unit = (int)atomicAdd(p.stats + 32, 1u);
    __syncthreads();
    const int u = s_unit;
    if (u >= 128 * 20 + 512) break;
    if (u < 128 * 20) {
      const int qt = 127 - u / 20, sidx = u % 20, bb = sidx / 10, wq = sidx % 10;
      const int hh = wq < 2 ? wq : (wq < 6 ? 2 : 3);
      const int ch = wq < 2 ? 0 : ((wq - 2) & 3);
      const int bh = bb * 4 + hh;
      const float q0m = __uint_as_float(p.stats[bh * 2]), q1m = __uint_as_float(p.stats[bh * 2 + 1]);
      const float k0m = __uint_as_float(p.stats[16 + bh * 2]), k1m = __uint_as_float(p.stats[16 + bh * 2 + 1]);
      const float B = 1.02f * fmaxf(sqrtf(q0m * k0m), sqrtf(q1m * k1m));
      const float slope2 = exp2f(-2.f * (float)(hh + 1)) * LOG2E;
      const float span = ((2.f * B + 45.f) / slope2 + 63.f) * (1.f / 64.f);
      int kt0 = 0;
      if (span < 200.f) { kt0 = qt - (int)span; if (kt0 < 0) kt0 = 0; }
      const int n = qt - kt0 + 1;
      int nch = 1;
      if (hh >= 2) nch = n > 48 ? 4 : (n > 20 ? 2 : 1);
      if (ch < nch) {
        const int len = (n + nch - 1) / nch;
        const int ktb = kt0 + ch * len;
        int kte = ktb + len; if (kte > qt + 1) kte = qt + 1;
        if (ktb < kte) attn_chunk(p, bb, hh, qt, ktb, kte, ch, nch, lam, smem, &s_flag);
        else if (nch > 1) {
          if (threadIdx.x == 0) atomicAdd(p.stats + 64 + (bh * 128 + qt), 1u);
        }
      }
    } else {
      const int g = u - 128 * 20;
      gmlp_unit(p, g >> 2, g & 3, smem);
    }
  }
}

DI void phase3(const Params& p, char* smem) {
  const int lane = threadIdx.x & 63, w = threadIdx.x >> 6, wm = w >> 1, wn = w & 1, r = lane & 31, h = lane >> 5;
  for (int t = blockIdx.x; t < 128 * 8; t += gridDim.x) {
    const int m0 = (t >> 3) * 128, n0 = (t & 7) * 128;
    f32x16 acc[2][2];
#pragma unroll
    for (int a = 0; a < 2; ++a)
#pragma unroll
      for (int b = 0; b < 2; ++b)
#pragma unroll
        for (int i = 0; i < 16; ++i) acc[a][b][i] = 0.f;
    gemm_tile<2, 2, false>(p.mixcat + (size_t)m0 * 1024, 1024, p.w_oT + (size_t)n0 * 1024, 1024, 1024, acc, smem);
    float* sC = (float*)smem;
#pragma unroll
    for (int half = 0; half < 2; ++half) {
      __syncthreads();
      if (wm == half) {
#pragma unroll
        for (int a = 0; a < 2; ++a)
#pragma unroll
          for (int b = 0; b < 2; ++b)
#pragma unroll
            for (int i = 0; i < 16; ++i) sC[(a * 32 + crow(i, h)) * 132 + wn * 64 + b * 32 + r] = acc[a][b][i];
      }
      __syncthreads();
#pragma unroll
      for (int i = 0; i < 8; ++i) {
        const int idx = threadIdx.x + 256 * i, t = idx >> 5, c = idx & 31;
        const f32x4 mv = *(const f32x4*)(sC + t * 132 + c * 4);
        const size_t o = (size_t)(m0 + half * 64 + t) * 1024 + n0 + c * 4;
        const f32x4 xv = *(const f32x4*)(p.x + o);
        f32x4 y;
#pragma unroll
        for (int j = 0; j < 4; ++j) y[j] = ALPHA * xv[j] + mv[j];
        u32x2 hv; hv[0] = pack_h2(y[0], y[1]); hv[1] = pack_h2(y[2], y[3]);
        *(u32x2*)((u16*)p.y1 + o) = hv;
      }
    }
  }
}

DI void phase3b(const Params& p) {
  const int lane = threadIdx.x & 63;
  const int gw = blockIdx.x * 4 + (threadIdx.x >> 6), nw = gridDim.x * 4;
  const u16* y1h = (const u16*)p.y1;
  for (int row = gw; row < T_TOK; row += nw) {
    const size_t ro = (size_t)row * 1024;
    float v[16];
    float s = 0.f;
#pragma unroll
    for (int i = 0; i < 2; ++i) {
      const h8_t hv = __builtin_bit_cast(h8_t, *(const u32x4*)(y1h + ro + i * 512 + lane * 8));
#pragma unroll
      for (int c = 0; c < 8; ++c) { v[i * 8 + c] = (float)hv[c]; s += v[i * 8 + c]; }
    }
    s = wave_sum(s);
    const float mu = s * (1.f / 1024.f);
    float q = 0.f;
#pragma unroll
    for (int i = 0; i < 16; ++i) { const float d = v[i] - mu; q += d * d; }
    q = wave_sum(q);
    const float rs = rsqrtf(q * (1.f / 1024.f) + LN_EPS);
#pragma unroll
    for (int i = 0; i < 2; ++i) {
      const int col = i * 512 + lane * 8;
      const f32x4 g0 = *(const f32x4*)(p.ln1g + col), g1 = *(const f32x4*)(p.ln1g + col + 4);
      const f32x4 b0 = *(const f32x4*)(p.ln1b + col), b1 = *(const f32x4*)(p.ln1b + col + 4);
      float y[8];
#pragma unroll
      for (int c = 0; c < 4; ++c) { y[c] = (v[i * 8 + c] - mu) * rs * g0[c] + b0[c]; y[4 + c] = (v[i * 8 + 4 + c] - mu) * rs * g1[c] + b1[c]; }
      u32x4 hv;
#pragma unroll
      for (int c = 0; c < 4; ++c) hv[c] = pack_h2(y[2 * c], y[2 * c + 1]);
      *(u32x4*)(p.x1h + ro + col) = hv;
    }
  }
}

DI u32 f2key(float f) { const u32 u = __float_as_uint(f); return (u & 0x80000000u) ? ~u : (u | 0x80000000u); }
DI float key2f(u32 k) { return __uint_as_float((k & 0x80000000u) ? (k & 0x7fffffffu) : ~k); }
DI u32 umax(u32 a, u32 b) { return a > b ? a : b; }
DI u32 umin(u32 a, u32 b) { return a < b ? a : b; }

DI void sort16_desc(u32 (&v)[16]) {
#pragma unroll
  for (int k = 2; k <= 16; k <<= 1)
#pragma unroll
    for (int j = k >> 1; j > 0; j >>= 1)
#pragma unroll
      for (int i = 0; i < 16; ++i) {
        const int l = i ^ j;
        if (l > i) {
          const u32 hi = umax(v[i], v[l]), lo = umin(v[i], v[l]);
          if ((i & k) == 0) { v[i] = hi; v[l] = lo; } else { v[i] = lo; v[l] = hi; }
        }
      }
}
DI void merge16_desc(u32 (&a)[16], const u32 (&b)[16]) {
#pragma unroll
  for (int i = 0; i < 16; ++i) a[i] = umax(a[i], b[15 - i]);
#pragma unroll
  for (int j = 8; j > 0; j >>= 1)
#pragma unroll
    for (int i = 0; i < 16; ++i) {
      const int l = i ^ j;
      if (l > i) { const u32 hi = umax(a[i], a[l]), lo = umin(a[i], a[l]); a[i] = hi; a[l] = lo; }
    }
}

DI void peer_route_unit(const Params& p, int tb, int head, char* smem) {
  const int tid = threadIdx.x, lane = tid & 63, w = tid >> 6, r = lane & 31, h = lane >> 5;
  const int tok0 = tb * 128;
  u32 top[2][16];
#pragma unroll
  for (int half = 0; half < 2; ++half) {
    f32x16 sc[4];
#pragma unroll
    for (int mt = 0; mt < 4; ++mt)
#pragma unroll
      for (int i = 0; i < 16; ++i) sc[mt][i] = 0.f;
    gemm_tile_n4<true>(p.w_qT + (size_t)((head * 2 + half) * 128) * 1024, 1024, p.x1h + (size_t)tok0 * 1024, 1024, 1024, sc, smem);
    u32 kv[4][16];
#pragma unroll
    for (int mt = 0; mt < 4; ++mt) {
#pragma unroll
      for (int i = 0; i < 16; ++i) {
        const int key = mt * 32 + crow(i, h);
        kv[mt][i] = (f2key(sc[mt][i]) & ~127u) | (u32)(127 - key);
      }
      sort16_desc(kv[mt]);
    }
    merge16_desc(kv[0], kv[1]);
    merge16_desc(kv[2], kv[3]);
    merge16_desc(kv[0], kv[2]);
    u32 other[16];
#pragma unroll
    for (int i = 0; i < 16; ++i) other[i] = (u32)__shfl_xor((int)kv[0][i], 32);
    merge16_desc(kv[0], other);
#pragma unroll
    for (int i = 0; i < 16; ++i) top[half][i] = kv[0][i];
  }
  __syncthreads();
  int* sIdx = (int*)smem;
  float va[16], vb[16];
#pragma unroll
  for (int i = 0; i < 16; ++i) {
    va[i] = key2f(top[0][i] & ~127u); vb[i] = key2f(top[1][i] & ~127u);
    sIdx[tid * 33 + i] = 127 - (int)(top[0][i] & 127u);
    sIdx[tid * 33 + 16 + i] = 127 - (int)(top[1][i] & 127u);
  }
  u32 cd[4][16];
  {
    u32 c[64];
    int n = 0;
#pragma unroll
    for (int i = 0; i < 16; ++i)
#pragma unroll
      for (int j = 0; j < 16; ++j)
        if ((i + 1) * (j + 1) <= 16) { c[n] = (f2key(va[i] + vb[j]) & ~255u) | (u32)(255 - (i * 16 + j)); ++n; }
#pragma unroll
    for (int q = 50; q < 64; ++q) c[q] = 0u;
#pragma unroll
    for (int g = 0; g < 4; ++g)
#pragma unroll
      for (int i = 0; i < 16; ++i) cd[g][i] = c[g * 16 + i];
  }
#pragma unroll
  for (int g = 0; g < 4; ++g) sort16_desc(cd[g]);
  merge16_desc(cd[0], cd[1]);
  merge16_desc(cd[2], cd[3]);
  merge16_desc(cd[0], cd[2]);
  float sv[16], sum = 0.f;
  const float mx = key2f(cd[0][0] & ~255u);
#pragma unroll
  for (int i = 0; i < 16; ++i) { sv[i] = __expf(key2f(cd[0][i] & ~255u) - mx); sum += sv[i]; }
  const float inv = 1.f / sum;
  if (h == 0) {
    const size_t o = (size_t)(tok0 + w * 32 + r) * 128 + head * 16;
#pragma unroll
    for (int q = 0; q < 4; ++q) {
      int e[4]; f32x4 g;
#pragma unroll
      for (int c = 0; c < 4; ++c) {
        const int code = 255 - (int)(cd[0][q * 4 + c] & 255u);
        const int ea = sIdx[tid * 33 + (code >> 4)], eb = sIdx[tid * 33 + 16 + (code & 15)];
        e[c] = ea * 128 + eb;
        g[c] = sv[q * 4 + c] * inv;
      }
      *(u32x4*)(p.eid + o + q * 4) = (u32x4){(u32)e[0], (u32)e[1], (u32)e[2], (u32)e[3]};
      *(f32x4*)(p.gate + o + q * 4) = g;
    }
  }
  __syncthreads();
}

DI void phase4(const Params& p, char* smem) {
  for (int u = blockIdx.x; u < 1024; u += gridDim.x) {
#pragma unroll 2
    for (int i = threadIdx.x; i < 2048; i += 256) {
      const size_t i8 = (size_t)u * 2048 + i;
      cvt8_fp8(p.pu, (unsigned char*)p.u16t, i8, 512.f);
      cvt8_fp8(p.pv, (unsigned char*)p.v16t, i8, 64.f);
    }
    peer_route_unit(p, u >> 3, u & 7, smem);
  }
}

template <int CTRL, int ROWMASK>
DI float dpp_f(float v) {
  return __int_as_float(__builtin_amdgcn_update_dpp(0, __float_as_int(v), CTRL, ROWMASK, 0xF, false));
}
DI float dpp_sum_uniform(float v) {
  v += dpp_f<0xB1, 0xF>(v);
  v += dpp_f<0x4E, 0xF>(v);
  v += dpp_f<0x141, 0xF>(v);
  v += dpp_f<0x140, 0xF>(v);
  v += dpp_f<0x142, 0xA>(v);
  v += dpp_f<0x143, 0xC>(v);
  return __int_as_float(__builtin_amdgcn_readlane(__float_as_int(v), 63));
}
DI void sort128(u32& a, u32& b, int lane) {
#pragma unroll
  for (int k = 2; k <= 128; k <<= 1) {
#pragma unroll
    for (int j = k >> 1; j > 0; j >>= 1) {
      const bool up = ((2 * lane) & k) == 0;
      if (j == 1) {
        const u32 lo = umin(a, b), hi = umax(a, b);
        a = up ? lo : hi; b = up ? hi : lo;
      } else {
        const int m = j >> 1;
        const u32 oa = (u32)__shfl_xor((int)a, m), ob = (u32)__shfl_xor((int)b, m);
        const bool lower = (lane & m) == 0;
        a = (lower == up) ? umin(a, oa) : umax(a, oa);
        b = (lower == up) ? umin(b, ob) : umax(b, ob);
      }
    }
  }
}

constexpr int P5T = 4;
struct BatchU { u32x4 ru[8]; };
struct BatchV { u32x4 rv[8]; u32 pe[8]; };
struct P5Tabs { __amdgpu_buffer_rsrc_t ur, vr; };

DI u32 p5_entry(const u32 (&v0)[P5T], const u32 (&v1)[P5T], int i, int j) {
  const int st = j >> 2, t = j & 3;
  return (u32)__builtin_amdgcn_readlane((int)(st ? v1[t] : v0[t]), i);
}
DI void p5_issue_u(const P5Tabs& tb_, BatchU& bu, const u32 (&v0)[P5T], const u32 (&v1)[P5T], int i, int loff) {
#pragma unroll
  for (int j = 0; j < 8; ++j) {
    const u32 pe = p5_entry(v0, v1, i, j);
    bu.ru[j] = __builtin_bit_cast(u32x4, __builtin_amdgcn_raw_buffer_load_b128(tb_.ur, loff, (int)((pe >> 18) << 10), 0));
  }
}
DI void p5_issue_v(const P5Tabs& tb_, BatchV& bv, const u32 (&v0)[P5T], const u32 (&v1)[P5T], int i, int loff) {
#pragma unroll
  for (int j = 0; j < 8; ++j) {
    const u32 pe = p5_entry(v0, v1, i, j);
    bv.pe[j] = pe;
    bv.rv[j] = __builtin_bit_cast(u32x4, __builtin_amdgcn_raw_buffer_load_b128(tb_.vr, loff, (int)((pe >> 18) << 10), 0));
  }
}

template <int CTRL>
DI float dppx(float v) { return __int_as_float(__builtin_amdgcn_update_dpp(0, __float_as_int(v), CTRL, 0xF, 0xF, false)); }

DI float p5_dots(const BatchU& bu, const u32 (&pe)[8], const h2_t (&xh)[P5T][8], int lane) {
  float dv[8];
#pragma unroll
  for (int j = 0; j < 8; ++j) {
    const int t = j & 3;
    float d0 = 0.f, d1 = 0.f;
#pragma unroll
    for (int i = 0; i < 4; ++i) {
      const h2_t c0 = __builtin_amdgcn_cvt_scalef32_pk_f16_fp8((int)bu.ru[j][i], 1.0f, false);
      const h2_t c1 = __builtin_amdgcn_cvt_scalef32_pk_f16_fp8((int)bu.ru[j][i], 1.0f, true);
      d0 = __builtin_amdgcn_fdot2(c0, xh[t][2 * i], d0, false);
      d1 = __builtin_amdgcn_fdot2(c1, xh[t][2 * i + 1], d1, false);
    }
    dv[j] = d0 + d1;
  }
  const bool b0 = lane & 1, b1 = lane & 2, b2 = lane & 4;
  float r[4];
#pragma unroll
  for (int k = 0; k < 4; ++k) {
    const float z0 = b0 ? dv[2 * k + 1] : dv[2 * k], z1 = b0 ? dv[2 * k] : dv[2 * k + 1];
    r[k] = z0 + dppx<0xB1>(z1);
  }
  float q[2];
#pragma unroll
  for (int k = 0; k < 2; ++k) {
    const float z0 = b1 ? r[2 * k + 1] : r[2 * k], z1 = b1 ? r[2 * k] : r[2 * k + 1];
    q[k] = z0 + dppx<0x4E>(z1);
  }
  float tt;
  {
    const float z0 = b2 ? q[1] : q[0], z1 = b2 ? q[0] : q[1];
    tt = z0 + __int_as_float(__builtin_amdgcn_ds_swizzle(__float_as_int(z1), 0x101F));
  }
  tt += dppx<0x128>(tt);
  tt += __int_as_float(__builtin_amdgcn_ds_swizzle(__float_as_int(tt), 0x401F));
  tt += __shfl_xor(tt, 32);
  int gi = 0;
#pragma unroll
  for (int j = 0; j < 8; ++j) {
    const int gv = __builtin_amdgcn_readfirstlane((int)(pe[j] & 0x3FFFFu));
    asm volatile("v_writelane_b32 %0, %1, %2" : "+v"(gi) : "s"(gv), "i"(j));
  }
  return (float)gi * (1.f / (262143.f * 64.f)) * gelu_fast(tt * (1.f / 512.f));
}
DI void p5_accum(const BatchV& bv, float wv, f2_t (&acc)[P5T][8]) {
#pragma unroll
  for (int j = 0; j < 8; ++j) {
    const int t = j & 3;
    const float wgt = __int_as_float(__builtin_amdgcn_readlane(__float_as_int(wv), j));
    const f2_t w2 = {wgt, wgt};
#pragma unroll
    for (int i = 0; i < 4; ++i) {
      const f2_t lo = __builtin_amdgcn_cvt_pk_f32_fp8((int)bv.rv[j][i], false);
      const f2_t hi = __builtin_amdgcn_cvt_pk_f32_fp8((int)bv.rv[j][i], true);
      acc[t][2 * i] = lo * w2 + acc[t][2 * i];
      acc[t][2 * i + 1] = hi * w2 + acc[t][2 * i + 1];
    }
  }
}

DI void phase5(const Params& p) {
  const int lane = threadIdx.x & 63;
  const int gw = blockIdx.x * 4 + (threadIdx.x >> 6), nw = gridDim.x * 4;
  P5Tabs tabs;
  tabs.ur = __builtin_amdgcn_make_buffer_rsrc((void*)p.u16t, 0, 16 << 20, 0x00020000);
  tabs.vr = __builtin_amdgcn_make_buffer_rsrc((void*)p.v16t, 0, 16 << 20, 0x00020000);
  for (int tb = gw * P5T; tb < T_TOK; tb += nw * P5T) {
    h2_t xh[P5T][8];
    u32 v0[P5T], v1[P5T];
    f2_t acc[P5T][8];
    int lp = lane;
    asm volatile("" : "+v"(lp));
#pragma unroll
    for (int t = 0; t < P5T; ++t) {
      const u32x4* xr = (const u32x4*)(p.x1h + (size_t)(tb + t) * 1024 + lp * 16);
      const h8_t xa = __builtin_bit_cast(h8_t, xr[0]), xb = __builtin_bit_cast(h8_t, xr[1]);
#pragma unroll
      for (int i = 0; i < 4; ++i) { xh[t][i] = (h2_t){xa[2 * i], xa[2 * i + 1]}; xh[t][4 + i] = (h2_t){xb[2 * i], xb[2 * i + 1]}; }
      const size_t eo = (size_t)(tb + t) * 128 + 2 * lp;
      const u32 ea = (u32)p.eid[eo], eb = (u32)p.eid[eo + 1];
      const float ga = p.gate[eo], gb = p.gate[eo + 1];
      u32 pa = (ea << 18) | (u32)(ga * 262143.f + 0.5f);
      u32 pb = (eb << 18) | (u32)(gb * 262143.f + 0.5f);
      sort128(pa, pb, lp);
      v0[t] = pa; v1[t] = pb;
#pragma unroll
      for (int i = 0; i < 8; ++i) acc[t][i] = (f2_t){0.f, 0.f};
    }
    BatchU U;
    BatchV V;
    const int rev = ((tb / (nw * P5T)) & 1) ? 63 : 0;
    p5_issue_u(tabs, U, v0, v1, rev, lane * 16);
    p5_issue_v(tabs, V, v0, v1, rev, lane * 16);
#pragma unroll 1
    for (int i = 0; i < 64; ++i) {
      const float wv = p5_dots(U, V.pe, xh, lane);
      if (i + 1 < 64) p5_issue_u(tabs, U, v0, v1, rev ^ (i + 1), lane * 16);
      p5_accum(V, wv, acc);
      if (i + 1 < 64) p5_issue_v(tabs, V, v0, v1, rev ^ (i + 1), lane * 16);
    }
    int le = lane;
    asm volatile("" : "+v"(le));
#pragma unroll
    for (int t = 0; t < P5T; ++t) {
      asm volatile("" ::: "memory");
      float y[16];
      float sm = 0.f;
#pragma unroll
      for (int e = 0; e < 16; ++e) {
        y[e] = ALPHA * (float)xh[t][e >> 1][e & 1] + acc[t][e >> 1][e & 1];
        sm += y[e];
      }
      sm = wave_sum(sm);
      const float mu = sm * (1.f / 1024.f);
      float qv = 0.f;
#pragma unroll
      for (int i = 0; i < 16; ++i) { const float dd = y[i] - mu; qv += dd * dd; }
      qv = wave_sum(qv);
      const float rsd = rsqrtf(qv * (1.f / 1024.f) + LN_EPS);
#pragma unroll
      for (int q = 0; q < 4; ++q) {
        const int col = le * 16 + q * 4;
        const f32x4 g = *(const f32x4*)(p.ln2g + col), be = *(const f32x4*)(p.ln2b + col);
        f32x4 o;
#pragma unroll
        for (int c = 0; c < 4; ++c) o[c] = (y[q * 4 + c] - mu) * rsd * g[c] + be[c];
        *(f32x4*)(p.out + (size_t)(tb + t) * 1024 + col) = o;
      }
    }
  }
}

#define XB_TMO      128
#define XB_XCNT(j)  (256  + 64 * (j))
#define XB_XSUB(j)  (1280 + 64 * (j))
#define XB_XGEN(j)  (2304 + 64 * (j))
#define XB_TOP      3328
#define XB_TOPGEN   3392
#define XCD_BAR_WORDS 3456
#define XB_SPIN_CAP (1u << 18)
#define LAS __attribute__((address_space(3)))
DI unsigned xb_ld(unsigned* p) { return __hip_atomic_load(p, __ATOMIC_RELAXED, __HIP_MEMORY_SCOPE_AGENT); }
DI unsigned xb_add(unsigned* p, unsigned v) { return __hip_atomic_fetch_add(p, v, __ATOMIC_RELAXED, __HIP_MEMORY_SCOPE_AGENT); }
DI unsigned xb_xcc_id() { return (unsigned)__builtin_amdgcn_s_getreg((3 << 11) | 20) & 0xFu; }
#define XB_SPIN(cond, bar) do { unsigned _sp = 0; while (cond) { __builtin_amdgcn_s_sleep(1); \
    if ((++_sp & 255u) == 0u) { if (xb_ld(&(bar)[XB_TMO])) break; if (_sp > XB_SPIN_CAP) { atomicAdd(&(bar)[XB_TMO], 1u); break; } } } } while (0)
struct XcdBarrier { unsigned* bar; unsigned x; volatile LAS unsigned* st; };
DI XcdBarrier xcd_barrier_post(unsigned* bar, volatile LAS unsigned* st) {
  XcdBarrier b; b.bar = bar; b.x = xb_xcc_id(); b.st = st;
  if (threadIdx.x == 0) (void)xb_add(&bar[XB_XCNT(b.x)], 1u);
  return b;
}
DI void xcd_barrier_complete(unsigned* bar, unsigned x, unsigned& nloc, unsigned& nx) {
  const unsigned G = gridDim.x * gridDim.y * gridDim.z;
  unsigned sum, cnt, mine, sp = 0u;
  for (;;) {
    sum = 0u; cnt = 0u; mine = 0u;
#pragma unroll
    for (unsigned j = 0; j < 16; ++j) { const unsigned c = xb_ld(&bar[XB_XCNT(j)]); sum += c; cnt += (c > 0u) ? 1u : 0u; mine = (j == x) ? c : mine; }
    if (sum == G) break;
    __builtin_amdgcn_s_sleep(1);
    if ((++sp & 255u) == 0u) { if (xb_ld(&bar[XB_TMO])) break; if (sp > XB_SPIN_CAP) { atomicAdd(&bar[XB_TMO], 1u); break; } }
  }
  nloc = mine > 0u ? mine : 1u; nx = cnt > 0u ? cnt : 1u;
}
DI void xcd_barrier(const XcdBarrier& b) {
  asm volatile("s_waitcnt vmcnt(0)" ::: "memory");
  __syncthreads();
  if (threadIdx.x == 0) {
    unsigned* bar = b.bar;
    __builtin_amdgcn_s_waitcnt(0);
    unsigned nloc = b.st[0], nx = b.st[1];
    if (nloc == 0u) { xcd_barrier_complete(bar, b.x, nloc, nx); b.st[0] = nloc; b.st[1] = nx; }
    const unsigned old = xb_add(&bar[XB_XSUB(b.x)], 1u);
    const unsigned gen = old / nloc;
    if (old + 1u == (gen + 1u) * nloc) {
      __builtin_amdgcn_fence(__ATOMIC_RELEASE, "agent");
      asm volatile("s_waitcnt vmcnt(0)" ::: "memory");
      const unsigned og = xb_add(&bar[XB_TOP], 1u);
      const unsigned tg = og / nx;
      if (og + 1u == (tg + 1u) * nx) xb_add(&bar[XB_TOPGEN], 1u);
      else XB_SPIN(xb_ld(&bar[XB_TOPGEN]) == tg, bar);
      __builtin_amdgcn_fence(__ATOMIC_ACQUIRE, "agent");
      xb_add(&bar[XB_XGEN(b.x)], 1u);
      asm volatile("s_waitcnt vmcnt(0)" ::: "memory");
    } else {
      XB_SPIN(xb_ld(&bar[XB_XGEN(b.x)]) == gen, bar);
      __builtin_amdgcn_fence(__ATOMIC_ACQUIRE, "agent");
      asm volatile("s_waitcnt vmcnt(0)" ::: "memory");
    }
  }
  __syncthreads();
}

__global__ void __launch_bounds__(256, 2) mega(Params p, int lo, int hi) {
  __shared__ __attribute__((aligned(16))) char smem[65536];
  __shared__ uint4 xb_words;
  cg::grid_group grid = cg::this_grid();
  if (lo > 1000) grid.sync();
  if (threadIdx.x == 0) xb_words = make_uint4(0u, 0u, 0u, 0u);
  __syncthreads();
  XcdBarrier xb = xcd_barrier_post(p.bar, (volatile LAS unsigned*)&xb_words);
#ifndef ONLY_PHASE
#define ONLY_PHASE -1
#endif
#define RUNPH(n) (lo <= n && n < hi && (ONLY_PHASE < 0 || ONLY_PHASE == n))
#define SYNCPH(n) if (lo <= n && n + 1 < hi) xcd_barrier(xb);
  if (RUNPH(0)) phase0(p, smem);
  SYNCPH(0)
  if (RUNPH(1)) phase1(p, smem);
  SYNCPH(1)
  if (RUNPH(2)) phase2(p, smem);
  SYNCPH(2)
  if (RUNPH(3)) phase3(p, smem);
  SYNCPH(3)
  if (RUNPH(3)) phase3b(p);
  SYNCPH(3)
  if (RUNPH(4)) phase4(p, smem);
  SYNCPH(4)
  if (RUNPH(5)) phase5(p);
}

extern "C" void kernel_launch(void* const* d_in, const int* in_sizes, int n_in, void* d_out, int out_size, void* d_ws,
                              size_t ws_size, hipStream_t stream) {
  Params p{};
  const float** f = (const float**)&p;
  for (int i = 0; i < 21; ++i) f[i] = (const float*)d_in[i];
  p.out = (float*)d_out;
  char* ws = (char*)d_ws;
  size_t off = 0;
  auto take = [&](size_t bytes) { char* r = ws + off; off += (bytes + 255) & ~(size_t)255; return r; };
  const size_t MB = 1u << 20;
  char* X = take(64 * MB);
  p.xb = (u16*)X; p.mixcat = p.xb;
  p.x1f = (float*)X;
  p.u16t = (u16*)take(16 * MB);
  p.v16t = (u16*)take(16 * MB);
  char* R = take(80 * MB);
  p.zu = (u16*)R; p.zvT = (u16*)(R + 16 * MB); p.qb = (u16*)(R + 32 * MB); p.kb = (u16*)(R + 48 * MB); p.vT = (u16*)(R + 64 * MB);
  p.y1 = (float*)R;
  p.w_inT = (u16*)take(5 * MB);
  p.w_oT = (u16*)take(2 * MB);
  p.w_qT = (u16*)take(4 * MB);
  p.keysh = (u16*)take(512 * 1024);
  p.wsb = (u16*)take(128 * 1024);
  p.bar = (unsigned*)take((XCD_BAR_WORDS + 64 + 1024) * 4);
  p.stats = p.bar + XCD_BAR_WORDS;
  p.lnst = (float*)take((size_t)T_TOK * 2 * 4);
  const size_t tail0 = off;
  p.x1h = (u16*)take(32 * MB);
  p.eid = (int*)take(8 * MB);
  p.gate = (float*)take(8 * MB);
  p.part = (char*)ws + tail0;
  if (tail0 + (size_t)2048 * ATT_SLOT > off) off = tail0 + (size_t)2048 * ATT_SLOT;
  if (off > ws_size) { fprintf(stderr, "workspace too small: need %zu have %zu\n", off, ws_size); return; }
  static int grid_blocks = 0;
  if (!grid_blocks) {
    int dev = 0, cus = 0, per_cu = 0;
    hipGetDevice(&dev);
    hipDeviceGetAttribute(&cus, hipDeviceAttributeMultiprocessorCount, dev);
    hipOccupancyMaxActiveBlocksPerMultiprocessor(&per_cu, mega, 256, 0);
    if (per_cu > 2) per_cu = 2;
    grid_blocks = cus * per_cu;
  }
  hipMemsetAsync(p.bar, 0, (XCD_BAR_WORDS + 64 + 1024) * 4, stream);
#ifdef MULTI_LAUNCH
  for (int ph = 0; ph < 6; ++ph) hipLaunchKernelGGL(mega, dim3(grid_blocks), dim3(256), 0, stream, p, ph, ph + 1);
#else
  int lo = 0, hi = 6;
  void* args[] = {&p, &lo, &hi};
  hipError_t e = hipLaunchCooperativeKernel((void*)mega, dim3(grid_blocks), dim3(256), args, 0, stream);
  if (e != hipSuccess) fprintf(stderr, "cooperative launch failed: %s (grid %d)\n", hipGetErrorString(e), grid_blocks);
#endif
}
```

```cpp
#include <hip/hip_runtime.h>
#include <hip/hip_cooperative_groups.h>
#include <cstdio>
namespace cg = cooperative_groups;

#define DI __device__ __forceinline__
typedef unsigned short u16;
typedef unsigned int u32;
typedef __attribute__((ext_vector_type(2))) __bf16 bf2_t;
typedef __attribute__((ext_vector_type(2))) float f2_t;
typedef __attribute__((ext_vector_type(2))) _Float16 h2_t;
typedef __attribute__((ext_vector_type(8))) _Float16 h8_t;
typedef __attribute__((ext_vector_type(8))) short s8_t;
typedef __attribute__((ext_vector_type(16))) float f32x16;
typedef __attribute__((ext_vector_type(4))) u32 u32x4;
typedef __attribute__((ext_vector_type(2))) u32 u32x2;
typedef __attribute__((ext_vector_type(4))) float f32x4;

constexpr int T_TOK = 16384;
constexpr int SEQ = 8192;
constexpr float ALPHA = 1.189207115002721f;
constexpr float LN_EPS = 1e-5f;
constexpr float LOG2E = 1.4426950408889634f;
#define LOG2E_C 1.4426950408889634f

struct Params {
  const float *x, *w_in, *gm_g, *gm_b, *gm_ws, *gm_bs, *lq1, *lk1, *lq2, *lk2, *da_g, *w_o, *ln1g, *ln1b,
      *w_q, *keys_a, *keys_b, *pu, *pv, *ln2g, *ln2b;
  float* out;
  u16 *xb, *mixcat, *u16t, *v16t, *zu, *zvT, *qb, *kb, *vT, *x1h, *w_inT, *w_oT, *w_qT, *keysh, *wsb;
  float* x1f;
  int* eid;
  float* gate;
  float* y1;
  unsigned* bar;
  float* lnst;
  char* part;
  unsigned* stats;
};

DI u32 pack_bf2(float a, float b) { f2_t v = {a, b}; bf2_t r = __builtin_convertvector(v, bf2_t); return __builtin_bit_cast(u32, r); }
DI u32 pack_h2(float a, float b) { f2_t v = {a, b}; h2_t r = __builtin_convertvector(v, h2_t); return __builtin_bit_cast(u32, r); }
DI float bf_lo(u32 u) { return __uint_as_float(u << 16); }
DI float bf_hi(u32 u) { return __uint_as_float(u & 0xffff0000u); }
DI float bf2f(u16 u) { return __uint_as_float(((u32)u) << 16); }
DI float gelu_f(float x) { return 0.5f * x * (1.f + erff(x * 0.70710678118654752f)); }
DI float gelu_fast(float x) {
  const float z = fabsf(x) * 0.70710678118654752f;
  const float t = __builtin_amdgcn_rcpf(1.f + 0.3275911f * z);
  const float poly = t * (0.254829592f + t * (-0.284496736f + t * (1.421413741f + t * (-1.453152027f + t * 1.061405429f))));
  const float e = poly * __builtin_amdgcn_exp2f(-z * z * LOG2E_C);
  const float erfabs = 1.f - e;
  const float erfv = x < 0.f ? -erfabs : erfabs;
  return 0.5f * x * (1.f + erfv);
}
DI float wave_sum(float v) {
#pragma unroll
  for (int o = 32; o > 0; o >>= 1) v += __shfl_xor(v, o);
  return v;
}
DI int ltid() { int t = threadIdx.x; asm volatile("" : "+v"(t)); return t; }
DI int crow(int i, int h) { return (i & 3) + 8 * (i >> 2) + 4 * h; }

template <bool F16>
DI f32x16 mfma32(u32x4 a, u32x4 b, f32x16 c) {
  if constexpr (F16)
    return __builtin_amdgcn_mfma_f32_32x32x16_f16(__builtin_bit_cast(h8_t, a), __builtin_bit_cast(h8_t, b), c, 0, 0, 0);
  else
    return __builtin_amdgcn_mfma_f32_32x32x16_bf16(__builtin_bit_cast(s8_t, a), __builtin_bit_cast(s8_t, b), c, 0, 0, 0);
}

template <int TM, int TN, bool F16>
DI void gemm_tile(const u16* __restrict__ A, int lda, const u16* __restrict__ B, int ldb, int K,
                  f32x16 (&acc)[TM][TN], char* smem) {
  static_assert(TM == 2 && TN == 2, "128x128 tile only");
  const int tid = ltid(), lane = tid & 63, w = tid >> 6, wm = w >> 1, wn = w & 1, r = lane & 31, h = lane >> 5;
  typedef __attribute__((address_space(1))) void gvoid;
  typedef __attribute__((address_space(3))) void lvoid;
  const u16* asrc[4];
  const u16* bsrc[4];
#pragma unroll
  for (int j = 0; j < 4; ++j) {
    const int row = (w * 4 + j) * 8 + (lane >> 3);
    const int c = (lane & 7) ^ ((row >> 1) & 7);
    asrc[j] = A + (size_t)row * lda + c * 8;
    bsrc[j] = B + (size_t)row * ldb + c * 8;
  }
  __syncthreads();
#pragma unroll
  for (int j = 0; j < 4; ++j) {
    __builtin_amdgcn_global_load_lds((const gvoid*)asrc[j], (lvoid*)(smem + (w * 4 + j) * 1024), 16, 0, 0);
    __builtin_amdgcn_global_load_lds((const gvoid*)bsrc[j], (lvoid*)(smem + 16384 + (w * 4 + j) * 1024), 16, 0, 0);
  }
  asm volatile("s_waitcnt vmcnt(0)" ::: "memory");
  __syncthreads();
  const int swz = (r >> 1) & 7;
  for (int k0 = 0; k0 < K; k0 += 64) {
    const char* buf = smem + ((k0 >> 6) & 1) * 32768;
    if (k0 + 64 < K) {
      char* nb = smem + (((k0 >> 6) + 1) & 1) * 32768;
#pragma unroll
      for (int j = 0; j < 4; ++j) {
        __builtin_amdgcn_global_load_lds((const gvoid*)(asrc[j] + k0 + 64), (lvoid*)(nb + (w * 4 + j) * 1024), 16, 0, 0);
        __builtin_amdgcn_global_load_lds((const gvoid*)(bsrc[j] + k0 + 64), (lvoid*)(nb + 16384 + (w * 4 + j) * 1024), 16, 0, 0);
      }
    }
#pragma unroll
    for (int ks = 0; ks < 4; ++ks) {
      u32x4 af[2], bfr[2];
      const int co = ((ks * 2 + h) ^ swz) << 4;
#pragma unroll
      for (int mt = 0; mt < 2; ++mt) af[mt] = *(const u32x4*)(buf + (wm * 64 + mt * 32 + r) * 128 + co);
#pragma unroll
      for (int nt = 0; nt < 2; ++nt) bfr[nt] = *(const u32x4*)(buf + 16384 + (wn * 64 + nt * 32 + r) * 128 + co);
#pragma unroll
      for (int mt = 0; mt < 2; ++mt)
#pragma unroll
        for (int nt = 0; nt < 2; ++nt) acc[mt][nt] = mfma32<F16>(af[mt], bfr[nt], acc[mt][nt]);
    }
    asm volatile("s_waitcnt vmcnt(0)" ::: "memory");
    __syncthreads();
  }
}

template <bool F16>
DI void gemm_tile_n4(const u16* __restrict__ A, int lda, const u16* __restrict__ B, int ldb, int K, f32x16 (&acc)[4], char* smem) {
  const int tid = ltid(), lane = tid & 63, w = tid >> 6, r = lane & 31, h = lane >> 5;
  typedef __attribute__((address_space(1))) void gvoid;
  typedef __attribute__((address_space(3))) void lvoid;
  const u16* asrc[4];
  const u16* bsrc[4];
#pragma unroll
  for (int j = 0; j < 4; ++j) {
    const int row = (w * 4 + j) * 8 + (lane >> 3);
    const int c = (lane & 7) ^ ((row >> 1) & 7);
    asrc[j] = A + (size_t)row * lda + c * 8;
    bsrc[j] = B + (size_t)row * ldb + c * 8;
  }
  __syncthreads();
#pragma unroll
  for (int j = 0; j < 4; ++j) {
    __builtin_amdgcn_global_load_lds((const gvoid*)asrc[j], (lvoid*)(smem + (w * 4 + j) * 1024), 16, 0, 0);
    __builtin_amdgcn_global_load_lds((const gvoid*)bsrc[j], (lvoid*)(smem + 16384 + (w * 4 + j) * 1024), 16, 0, 0);
  }
  asm volatile("s_waitcnt vmcnt(0)" ::: "memory");
  __syncthreads();
  const int swz = (r >> 1) & 7;
  for (int k0 = 0; k0 < K; k0 += 64) {
    const char* buf = smem + ((k0 >> 6) & 1) * 32768;
    if (k0 + 64 < K) {
      char* nb = smem + (((k0 >> 6) + 1) & 1) * 32768;
#pragma unroll
      for (int j = 0; j < 4; ++j) {
        __builtin_amdgcn_global_load_lds((const gvoid*)(asrc[j] + k0 + 64), (lvoid*)(nb + (w * 4 + j) * 1024), 16, 0, 0);
        __builtin_amdgcn_global_load_lds((const gvoid*)(bsrc[j] + k0 + 64), (lvoid*)(nb + 16384 + (w * 4 + j) * 1024), 16, 0, 0);
      }
    }
#pragma unroll
    for (int ks = 0; ks < 4; ++ks) {
      const int co = ((ks * 2 + h) ^ swz) << 4;
      const u32x4 bfr = *(const u32x4*)(buf + 16384 + (w * 32 + r) * 128 + co);
      u32x4 af[4];
#pragma unroll
      for (int mt = 0; mt < 4; ++mt) af[mt] = *(const u32x4*)(buf + (mt * 32 + r) * 128 + co);
#pragma unroll
      for (int mt = 0; mt < 4; ++mt) acc[mt] = mfma32<F16>(af[mt], bfr, acc[mt]);
    }
    asm volatile("s_waitcnt vmcnt(0)" ::: "memory");
    __syncthreads();
  }
}

template <bool F16>
DI void gemm_tile_n8(const u16* __restrict__ A, int lda, const u16* __restrict__ B, int ldb, int K, f32x16 (&acc)[8], char* smem) {
  const int tid = ltid(), lane = tid & 63, w = tid >> 6, r = lane & 31, h = lane >> 5;
  typedef __attribute__((address_space(1))) void gvoid;
  typedef __attribute__((address_space(3))) void lvoid;
  const u16* asrc[4];
  const u16* bsrc[2];
#pragma unroll
  for (int j = 0; j < 4; ++j) {
    const int row = (w * 4 + j) * 16 + (lane >> 2);
    asrc[j] = A + (size_t)row * lda + (((lane & 3) ^ ((row >> 2) & 3)) << 3);
  }
#pragma unroll
  for (int j = 0; j < 2; ++j) {
    const int row = (w * 2 + j) * 16 + (lane >> 2);
    bsrc[j] = B + (size_t)row * ldb + (((lane & 3) ^ ((row >> 2) & 3)) << 3);
  }
  __syncthreads();
#pragma unroll
  for (int j = 0; j < 4; ++j) __builtin_amdgcn_global_load_lds((const gvoid*)asrc[j], (lvoid*)(smem + (w * 4 + j) * 1024), 16, 0, 0);
#pragma unroll
  for (int j = 0; j < 2; ++j) __builtin_amdgcn_global_load_lds((const gvoid*)bsrc[j], (lvoid*)(smem + 16384 + (w * 2 + j) * 1024), 16, 0, 0);
  asm volatile("s_waitcnt vmcnt(0)" ::: "memory");
  __syncthreads();
  const int swz = (r >> 2) & 3;
  for (int k0 = 0; k0 < K; k0 += 32) {
    const char* buf = smem + ((k0 >> 5) & 1) * 24576;
    if (k0 + 32 < K) {
      char* nb = smem + (((k0 >> 5) + 1) & 1) * 24576;
#pragma unroll
      for (int j = 0; j < 4; ++j) __builtin_amdgcn_global_load_lds((const gvoid*)(asrc[j] + k0 + 32), (lvoid*)(nb + (w * 4 + j) * 1024), 16, 0, 0);
#pragma unroll
      for (int j = 0; j < 2; ++j) __builtin_amdgcn_global_load_lds((const gvoid*)(bsrc[j] + k0 + 32), (lvoid*)(nb + 16384 + (w * 2 + j) * 1024), 16, 0, 0);
    }
#pragma unroll
    for (int ks = 0; ks < 2; ++ks) {
      const int co = ((ks * 2 + h) ^ swz) << 4;
      const u32x4 bfr = *(const u32x4*)(buf + 16384 + (w * 32 + r) * 64 + co);
#pragma unroll
      for (int mt = 0; mt < 8; ++mt) {
        const u32x4 af = *(const u32x4*)(buf + (mt * 32 + r) * 64 + co);
        acc[mt] = mfma32<F16>(af, bfr, acc[mt]);
      }
    }
    asm volatile("s_waitcnt vmcnt(0)" ::: "memory");
    __syncthreads();
  }
}

DI void wk_tile(const Params& p, int hh16, int nt, char* smem) {
  const int tid = threadIdx.x, lane = tid & 63, w = tid >> 6, wm = w >> 1, wn = w & 1, r = lane & 31, h = lane >> 5;
  u16* sA = (u16*)smem;
  u16* sB = sA + 128 * 72;
  const float* ksrc = ((hh16 & 1) ? p.keys_b : p.keys_a) + (size_t)(hh16 >> 1) * 16384;
  const float* wsrc = p.w_q + (size_t)(nt * 128) * 2048 + hh16 * 128;
  f32x16 acc[2][2];
#pragma unroll
  for (int a = 0; a < 2; ++a)
#pragma unroll
    for (int b = 0; b < 2; ++b)
#pragma unroll
      for (int i = 0; i < 16; ++i) acc[a][b][i] = 0.f;
  for (int dh = 0; dh < 2; ++dh) {
    __syncthreads();
#pragma unroll
    for (int i = 0; i < 8; ++i) {
      const int idx = tid + 256 * i, row = idx >> 4, c4 = (idx & 15) * 4;
      const f32x4 kv = *(const f32x4*)(ksrc + row * 128 + dh * 64 + c4);
      const f32x4 wv = *(const f32x4*)(wsrc + (size_t)row * 2048 + dh * 64 + c4);
      *(u32x2*)(sA + row * 72 + c4) = (u32x2){pack_h2(kv[0], kv[1]), pack_h2(kv[2], kv[3])};
      *(u32x2*)(sB + row * 72 + c4) = (u32x2){pack_h2(wv[0], wv[1]), pack_h2(wv[2], wv[3])};
    }
    __syncthreads();
#pragma unroll
    for (int ks = 0; ks < 4; ++ks) {
      u32x4 af[2], bfr[2];
#pragma unroll
      for (int mt = 0; mt < 2; ++mt) af[mt] = *(const u32x4*)(sA + (wm * 64 + mt * 32 + r) * 72 + ks * 16 + 8 * h);
#pragma unroll
      for (int nt2 = 0; nt2 < 2; ++nt2) bfr[nt2] = *(const u32x4*)(sB + (wn * 64 + nt2 * 32 + r) * 72 + ks * 16 + 8 * h);
#pragma unroll
      for (int mt = 0; mt < 2; ++mt)
#pragma unroll
        for (int nt2 = 0; nt2 < 2; ++nt2) acc[mt][nt2] = mfma32<true>(af[mt], bfr[nt2], acc[mt][nt2]);
    }
  }
  u16* dst = p.w_qT + (size_t)hh16 * 128 * 1024 + nt * 128;
#pragma unroll
  for (int a = 0; a < 2; ++a)
#pragma unroll
    for (int b = 0; b < 2; ++b)
#pragma unroll
      for (int i = 0; i < 16; ++i)
        dst[(size_t)(wm * 64 + a * 32 + crow(i, h)) * 1024 + wn * 64 + b * 32 + r] = (u16)(pack_h2(acc[a][b][i], 0.f) & 0xffff);
}

template <bool F16>
DI void cvt8(const float* __restrict__ src, u16* __restrict__ dst, size_t i8) {
  const f32x4 a = *(const f32x4*)(src + i8 * 8), b = *(const f32x4*)(src + i8 * 8 + 4);
  u32x4 o;
  if constexpr (F16) { o[0] = pack_h2(a[0], a[1]); o[1] = pack_h2(a[2], a[3]); o[2] = pack_h2(b[0], b[1]); o[3] = pack_h2(b[2], b[3]); }
  else { o[0] = pack_bf2(a[0], a[1]); o[1] = pack_bf2(a[2], a[3]); o[2] = pack_bf2(b[0], b[1]); o[3] = pack_bf2(b[2], b[3]); }
  *(u32x4*)(dst + i8 * 8) = o;
}

DI void cvt8_fp8(const float* __restrict__ src, unsigned char* __restrict__ dst, size_t i8, float sc) {
  const f32x4 a = *(const f32x4*)(src + i8 * 8), b = *(const f32x4*)(src + i8 * 8 + 4);
  int w0 = 0, w1 = 0;
  w0 = __builtin_amdgcn_cvt_pk_fp8_f32(a[0] * sc, a[1] * sc, w0, false);
  w0 = __builtin_amdgcn_cvt_pk_fp8_f32(a[2] * sc, a[3] * sc, w0, true);
  w1 = __builtin_amdgcn_cvt_pk_fp8_f32(b[0] * sc, b[1] * sc, w1, false);
  w1 = __builtin_amdgcn_cvt_pk_fp8_f32(b[2] * sc, b[3] * sc, w1, true);
  *(u32x2*)(dst + i8 * 8) = (u32x2){(u32)w0, (u32)w1};
}

template <bool F16>
DI void transpose_tile(const float* __restrict__ W, int N, u16* __restrict__ WT, int kt, int nt, char* smem) {
  float* sT = (float*)smem;
  const int tid = threadIdx.x;
  __syncthreads();
#pragma unroll
  for (int i = 0; i < 4; ++i) {
    const int row = (tid >> 4) + 16 * i, c4 = (tid & 15) * 4;
    const f32x4 v = *(const f32x4*)(W + (size_t)(kt * 64 + row) * N + nt * 64 + c4);
    sT[row * 65 + c4 + 0] = v[0]; sT[row * 65 + c4 + 1] = v[1]; sT[row * 65 + c4 + 2] = v[2]; sT[row * 65 + c4 + 3] = v[3];
  }
  __syncthreads();
  const int n = tid >> 2, ks = (tid & 3) * 16;
  u32 o[8];
#pragma unroll
  for (int j = 0; j < 8; ++j) {
    const float a = sT[(ks + 2 * j) * 65 + n], b = sT[(ks + 2 * j + 1) * 65 + n];
    o[j] = F16 ? pack_h2(a, b) : pack_bf2(a, b);
  }
  u16* d = WT + (size_t)(nt * 64 + n) * 1024 + kt * 64 + ks;
  *(u32x4*)d = (u32x4){o[0], o[1], o[2], o[3]};
  *(u32x4*)(d + 8) = (u32x4){o[4], o[5], o[6], o[7]};
}

DI void phase0(const Params& p, char* smem) {
  const size_t gt = (size_t)blockIdx.x * 256 + threadIdx.x, gs = (size_t)gridDim.x * 256;
  for (size_t i = gt; i < (size_t)T_TOK * 1024 / 8; i += gs) cvt8<false>(p.x, p.xb, i);
  for (size_t i = gt; i < (size_t)T_TOK * 2; i += gs) p.lnst[i] = 0.f;
  for (size_t i = gt; i < 131072 / 8; i += gs) { cvt8<true>(p.keys_a, p.keysh, i); cvt8<true>(p.keys_b, p.keysh + 131072, i); }
  for (size_t i = gt; i < 65536; i += gs) {
    const int t = (i >> 7) & 127, s = i & 127;
    p.wsb[i] = (u16)(pack_bf2(s <= t ? p.gm_ws[i] : 0.f, 0.f) & 0xffff);
  }
  for (int t = blockIdx.x; t < 640 + 256 + 128; t += gridDim.x) {
    if (t < 640) transpose_tile<false>(p.w_in, 2560, p.w_inT, t / 40, t % 40, smem);
    else if (t < 896) transpose_tile<false>(p.w_o, 1024, p.w_oT, (t - 640) / 16, (t - 640) % 16, smem);
    else wk_tile(p, (t - 896) >> 3, (t - 896) & 7, smem);
  }
}

DI void phase1(const Params& p, char* smem) {
  const int lane = threadIdx.x & 63, w = threadIdx.x >> 6, wm = w >> 1, wn = w & 1, r = lane & 31, h = lane >> 5;
  for (int t = blockIdx.x; t < 128 * 20; t += gridDim.x) {
    const int mt_ = t / 20, nt_ = t % 20;
    const int m0 = mt_ * 128, n0 = nt_ * 128;
    const bool swapped = (n0 >= 512 && n0 < 1024) || (n0 >= 2048);
    f32x16 acc[2][2];
#pragma unroll
    for (int a = 0; a < 2; ++a)
#pragma unroll
      for (int b = 0; b < 2; ++b)
#pragma unroll
        for (int i = 0; i < 16; ++i) acc[a][b][i] = 0.f;
    if (!swapped) {
      gemm_tile<2, 2, false>(p.xb + (size_t)m0 * 1024, 1024, p.w_inT + (size_t)n0 * 1024, 1024, 1024, acc, smem);
      u16* dst; int cb; int mode;
      if (n0 < 512) { dst = p.zu; cb = n0; mode = 0; }
      else if (n0 < 1536) { dst = p.qb; cb = n0 - 1024; mode = 1; }
      else { dst = p.kb; cb = n0 - 1536; mode = 2; }
      float nmax = 0.f;
      u16* sC = (u16*)smem;
      __syncthreads();
#pragma unroll
      for (int a = 0; a < 2; ++a)
#pragma unroll
        for (int i = 0; i < 16; ++i) {
          float sq = 0.f;
#pragma unroll
          for (int b = 0; b < 2; ++b) {
            float v = acc[a][b][i];
            if (mode == 0) v = gelu_fast(v);
            else if (mode == 1) v *= 0.125f * LOG2E;
            const u32 pk = pack_bf2(v, 0.f);
            const float vr = bf_lo(pk);
            sq += vr * vr;
            sC[(wm * 64 + a * 32 + crow(i, h)) * 136 + wn * 64 + b * 32 + r] = (u16)(pk & 0xffff);
          }
          if (mode != 0) {
#pragma unroll
            for (int o = 1; o < 32; o <<= 1) sq += __shfl_xor(sq, o);
            nmax = fmaxf(nmax, sq);
          }
        }
      if (mode != 0) {
        nmax = fmaxf(nmax, __shfl_xor(nmax, 32));
        if (lane == 0) atomicMax(p.stats + (mode == 2 ? 16 : 0) + ((m0 >> 13) * 4 + (cb >> 7)) * 2 + wn, __float_as_uint(nmax));
      }
      __syncthreads();
#pragma unroll
      for (int i = 0; i < 8; ++i) {
        const int idx = threadIdx.x + 256 * i, t = idx >> 4, c = idx & 15;
        *(u32x4*)(dst + (size_t)(m0 + t) * 512 + cb + c * 8) = *(const u32x4*)(sC + t * 136 + c * 8);
      }
    } else {
      gemm_tile<2, 2, false>(p.w_inT + (size_t)n0 * 1024, 1024, p.xb + (size_t)m0 * 1024, 1024, 1024, acc, smem);
      const bool isz = n0 < 1024;
      u16* dst = isz ? p.zvT : p.vT;
      const int cb = isz ? n0 - 512 : n0 - 2048;
      const int bb = m0 >> 13, s0 = m0 & 8191;
      u16* sC = (u16*)smem;
      __syncthreads();
#pragma unroll
      for (int a = 0; a < 2; ++a)
#pragma unroll
        for (int b = 0; b < 2; ++b)
#pragma unroll
          for (int i = 0; i < 16; ++i) {
            float v = acc[a][b][i];
            if (isz) v = gelu_fast(v);
            const u32 pk = pack_bf2(v, 0.f);
            acc[a][b][i] = bf_lo(pk);
            sC[(wm * 64 + a * 32 + crow(i, h)) * 136 + wn * 64 + b * 32 + r] = (u16)(pk & 0xffff);
          }
      if (isz) {
#pragma unroll
        for (int b = 0; b < 2; ++b) {
          float sm = 0.f, sq = 0.f;
#pragma unroll
          for (int a = 0; a < 2; ++a)
#pragma unroll
            for (int i = 0; i < 16; ++i) { const float v = acc[a][b][i]; sm += v; sq += v * v; }
          sm += __shfl_xor(sm, 32); sq += __shfl_xor(sq, 32);
          if (h == 0) {
            float* st = p.lnst + (size_t)(m0 + wn * 64 + b * 32 + r) * 2;
            atomicAdd(st, sm); atomicAdd(st + 1, sq);
          }
        }
      }
      __syncthreads();
#pragma unroll
      for (int i = 0; i < 8; ++i) {
        const int idx = threadIdx.x + 256 * i, t = idx >> 4, c = idx & 15;
        *(u32x4*)(dst + ((size_t)bb * 512 + cb + t) * SEQ + s0 + c * 8) = *(const u32x4*)(sC + t * 136 + c * 8);
      }
    }
  }
}

DI void gmlp_unit(const Params& p, int chunk, int hh, char* smem) {
  const int tid = ltid(), lane = tid & 63, w = tid >> 6, wm = w >> 1, wn = w & 1, r = lane & 31, h = lane >> 5;
  const int tok0 = chunk * 128, bb = tok0 >> 13, s0 = tok0 & 8191;
  float* sMu = (float*)smem;
  float* sRs = sMu + 128;
  float* sPart = sRs + 128;
  u16* sA = (u16*)(smem + 17408);
  u16* sB = sA + 128 * 72;
  __syncthreads();
  if (tid < 128) {
    const float sa = p.lnst[(size_t)(tok0 + tid) * 2], sb = p.lnst[(size_t)(tok0 + tid) * 2 + 1];
    const float mu = sa * (1.f / 512.f);
    const float var = fmaxf(sb * (1.f / 512.f) - mu * mu, 0.f);
    sMu[tid] = mu; sRs[tid] = rsqrtf(var + LN_EPS);
  }
  f32x16 acc[2][2];
#pragma unroll
  for (int a = 0; a < 2; ++a)
#pragma unroll
    for (int b = 0; b < 2; ++b)
#pragma unroll
      for (int i = 0; i < 16; ++i) acc[a][b][i] = 0.f;
  for (int kh = 0; kh < 2; ++kh) {
    __syncthreads();
#pragma unroll
    for (int i = 0; i < 4; ++i) {
      const int idx = tid + 256 * i, row = idx >> 3, c = idx & 7;
      *(u32x4*)(sA + row * 72 + c * 8) = *(const u32x4*)(p.wsb + (size_t)hh * 16384 + row * 128 + kh * 64 + c * 8);
      const int ch = hh * 128 + row;
      const u32x4 v = *(const u32x4*)(p.zvT + ((size_t)bb * 512 + ch) * SEQ + s0 + kh * 64 + c * 8);
      const float g = p.gm_g[ch], be = p.gm_b[ch];
      u32x4 o;
#pragma unroll
      for (int j = 0; j < 4; ++j) {
        const int s = kh * 64 + c * 8 + 2 * j;
        const float a = (bf_lo(v[j]) - sMu[s]) * sRs[s] * g + be;
        const float b = (bf_hi(v[j]) - sMu[s + 1]) * sRs[s + 1] * g + be;
        o[j] = pack_bf2(a, b);
      }
      *(u32x4*)(sB + row * 72 + c * 8) = o;
    }
    __syncthreads();
#pragma unroll
    for (int ks = 0; ks < 4; ++ks) {
      u32x4 af[2], bfr[2];
#pragma unroll
      for (int mt = 0; mt < 2; ++mt) af[mt] = *(const u32x4*)(sA + (wm * 64 + mt * 32 + r) * 72 + ks * 16 + 8 * h);
#pragma unroll
      for (int nt = 0; nt < 2; ++nt) bfr[nt] = *(const u32x4*)(sB + (wn * 64 + nt * 32 + r) * 72 + ks * 16 + 8 * h);
#pragma unroll
      for (int mt = 0; mt < 2; ++mt)
#pragma unroll
        for (int nt = 0; nt < 2; ++nt) acc[mt][nt] = mfma32<false>(af[mt], bfr[nt], acc[mt][nt]);
    }
  }
  __syncthreads();
  {
    u16* sC = (u16*)smem;
#pragma unroll
    for (int a = 0; a < 2; ++a)
#pragma unroll
      for (int i = 0; i < 16; ++i) {
        const int t = wm * 64 + a * 32 + crow(i, h);
        const float bs = p.gm_bs[hh * 128 + t];
#pragma unroll
        for (int b = 0; b < 2; ++b) sC[t * 136 + wn * 64 + b * 32 + r] = (u16)(pack_bf2(acc[a][b][i] + bs, 0.f) & 0xffff);
      }
    __syncthreads();
#pragma unroll
    for (int i = 0; i < 8; ++i) {
      const int idx = tid + 256 * i, t = idx >> 4, c = idx & 15;
      const u32x4 mv = *(const u32x4*)(sC + t * 136 + c * 8);
      const u32x4 uv = *(const u32x4*)(p.zu + (size_t)(tok0 + t) * 512 + hh * 128 + c * 8);
      u32x4 o;
#pragma unroll
      for (int j = 0; j < 4; ++j) o[j] = pack_bf2(bf_lo(mv[j]) * bf_lo(uv[j]), bf_hi(mv[j]) * bf_hi(uv[j]));
      *(u32x4*)(p.mixcat + (size_t)(tok0 + t) * 1024 + hh * 128 + c * 8) = o;
    }
  }
}

DI void attn_core(const Params& p, int bb, int hh, int qt, int ktb, int kte, char* smem, f32x16 (&O)[4], float& m_out, float& l_out) {
  const int tid = ltid(), lane = tid & 63, w = tid >> 6, r = lane & 31, h = lane >> 5;
  const int map = w >> 1, qs = w & 1;
  const size_t tok0 = (size_t)bb * SEQ;
  const int q0 = qt * 64;
  const float slope2 = exp2f(-2.f * (float)(hh + 1)) * LOG2E;
  u32x4 qf[4];
  {
    const u16* qptr = p.qb + (tok0 + q0 + qs * 32 + r) * 512 + hh * 128 + map * 64 + 8 * h;
#pragma unroll
    for (int ks = 0; ks < 4; ++ks) qf[ks] = *(const u32x4*)(qptr + ks * 16);
  }
#pragma unroll
  for (int d = 0; d < 4; ++d)
#pragma unroll
    for (int i = 0; i < 16; ++i) O[d][i] = 0.f;
  float m = -1e30f, l = 0.f;
  const u16* kbase = p.kb + tok0 * 512 + hh * 128;
  const u16* vbase = p.vT + (size_t)(bb * 4 + hh) * 128 * SEQ;
  u32 koff[4], voff[4];
#pragma unroll
  for (int j = 0; j < 4; ++j) {
    const int krow = (w * 4 + j) * 4 + (lane >> 4);
    koff[j] = (u32)(krow * 512 + (((lane & 15) ^ (krow & 15)) << 3));
    const int vrow = (w * 4 + j) * 8 + (lane >> 3);
    voff[j] = (u32)(vrow * SEQ + (((lane & 7) ^ ((vrow >> 1) & 7)) << 3));
  }
  const int kr = (r & ~12) | ((r & 4) << 1) | ((r & 8) >> 1);
  const float hb = slope2 * (float)(8 * h);
  typedef __attribute__((address_space(1))) void gvoid;
  typedef __attribute__((address_space(3))) void lvoid;
  __syncthreads();
  {
    char* buf = smem + (ktb & 1) * 32768;
#pragma unroll
    for (int j = 0; j < 4; ++j) {
      __builtin_amdgcn_global_load_lds((const gvoid*)(kbase + (size_t)ktb * 64 * 512 + koff[j]), (lvoid*)(buf + (w * 4 + j) * 1024), 16, 0, 0);
      __builtin_amdgcn_global_load_lds((const gvoid*)(vbase + (size_t)ktb * 64 + voff[j]), (lvoid*)(buf + 16384 + (w * 4 + j) * 1024), 16, 0, 0);
    }
  }
  asm volatile("s_waitcnt vmcnt(0)" ::: "memory");
  __syncthreads();
  for (int kt = ktb; kt < kte; ++kt) {
    const char* buf = smem + (kt & 1) * 32768;
    if (kt + 1 < kte) {
      char* nb = smem + ((kt + 1) & 1) * 32768;
#pragma unroll
      for (int j = 0; j < 4; ++j) {
        __builtin_amdgcn_global_load_lds((const gvoid*)(kbase + (size_t)(kt + 1) * 64 * 512 + koff[j]), (lvoid*)(nb + (w * 4 + j) * 1024), 16, 0, 0);
        __builtin_amdgcn_global_load_lds((const gvoid*)(vbase + (size_t)(kt + 1) * 64 + voff[j]), (lvoid*)(nb + 16384 + (w * 4 + j) * 1024), 16, 0, 0);
      }
    }
    f32x16 S[2];
    {
      float hb2 = hb, sl = slope2;
      asm volatile("" : "+v"(hb2), "+v"(sl));
#pragma unroll
      for (int mt = 0; mt < 2; ++mt)
#pragma unroll
        for (int i = 0; i < 16; ++i) {
          if ((i & 7) == 0) S[mt][i] = hb2 + sl * (float)(32 * mt + 16 * (i >> 3));
          else S[mt][i] = S[mt][i - 1] + sl;
        }
    }
#pragma unroll
    for (int mt = 0; mt < 2; ++mt) {
      u32x4 af[4];
#pragma unroll
      for (int ks = 0; ks < 4; ++ks)
        af[ks] = *(const u32x4*)(buf + (mt * 32 + kr) * 256 + (((map * 8 + ks * 2 + h) ^ (kr & 15)) << 4));
#pragma unroll
      for (int ks = 0; ks < 4; ++ks) S[mt] = mfma32<false>(af[ks], qf[ks], S[mt]);
    }
    if (kt > ktb) m -= slope2 * 64.f;
    if (kt == qt) {
      const int qrel = qs * 32 + r;
#pragma unroll
      for (int mt = 0; mt < 2; ++mt)
#pragma unroll
        for (int i = 0; i < 16; ++i) {
          const int keyrel = 32 * mt + 16 * (i >> 3) + 8 * h + (i & 7);
          if (keyrel > qrel) S[mt][i] = -1e30f;
        }
    }
    float mx = S[0][0];
#pragma unroll
    for (int i = 1; i < 16; ++i) mx = fmaxf(mx, S[0][i]);
#pragma unroll
    for (int i = 0; i < 16; ++i) mx = fmaxf(mx, S[1][i]);
    mx = fmaxf(mx, __shfl_xor(mx, 32));
    if (__any(mx > m + 8.f)) {
      const float mn = fmaxf(m, mx);
      const float alpha = __builtin_amdgcn_exp2f(m - mn);
      m = mn;
      l *= alpha;
#pragma unroll
      for (int d = 0; d < 4; ++d)
#pragma unroll
        for (int i = 0; i < 16; ++i) O[d][i] *= alpha;
    }
    float ls = 0.f;
#pragma unroll
    for (int mt = 0; mt < 2; ++mt)
#pragma unroll
      for (int i = 0; i < 16; ++i) { const float e = __builtin_amdgcn_exp2f(S[mt][i] - m); S[mt][i] = e; ls += e; }
    l += ls;
#pragma unroll
    for (int mt = 0; mt < 2; ++mt)
#pragma unroll
      for (int s2 = 0; s2 < 2; ++s2) {
        u32x4 pf;
#pragma unroll
        for (int j = 0; j < 4; ++j) pf[j] = pack_bf2(S[mt][8 * s2 + 2 * j], S[mt][8 * s2 + 2 * j + 1]);
        u32x4 vf[4];
#pragma unroll
        for (int d = 0; d < 4; ++d)
          vf[d] = *(const u32x4*)(buf + 16384 + (d * 32 + r) * 128 + (((mt * 4 + s2 * 2 + h) ^ ((r >> 1) & 7)) << 4));
#pragma unroll
        for (int d = 0; d < 4; ++d) O[d] = mfma32<false>(vf[d], pf, O[d]);
      }
    asm volatile("s_waitcnt vmcnt(0)" ::: "memory");
    __syncthreads();
  }
  m_out = m; l_out = l;
}

DI void attn_finish(const Params& p, int bb, int hh, int qt, float lam, char* smem, f32x16 (&O)[4], float inv) {
  const int tid = ltid(), lane = tid & 63, w = tid >> 6, r = lane & 31, h = lane >> 5;
  const int map = w >> 1, qs = w & 1;
  const size_t tok0 = (size_t)bb * SEQ;
  const int q0 = qt * 64;
  __syncthreads();
  float* sC = (float*)smem;
  if (map == 1) {
    const float sc = inv * lam;
#pragma unroll
    for (int d = 0; d < 4; ++d)
#pragma unroll
      for (int i = 0; i < 16; ++i) sC[(qs * 64 + d * 16 + i) * 64 + lane] = O[d][i] * sc;
  }
  __syncthreads();
  if (map == 0) {
    float ss = 0.f;
#pragma unroll
    for (int d = 0; d < 4; ++d)
#pragma unroll
      for (int i = 0; i < 16; ++i) {
        const float v = O[d][i] * inv - sC[(qs * 64 + d * 16 + i) * 64 + lane];
        O[d][i] = v; ss += v * v;
      }
    ss += __shfl_xor(ss, 32);
    const float rs = rsqrtf(ss * (1.f / 128.f) + LN_EPS) * 0.8f;
    u16* dst = p.mixcat + (tok0 + q0 + qs * 32 + r) * 1024 + 512 + hh * 128;
#pragma unroll
    for (int d = 0; d < 4; ++d)
#pragma unroll
      for (int i4 = 0; i4 < 4; ++i4) {
        const int dv0 = d * 32 + 8 * i4 + 4 * h;
        const f32x4 g = *(const f32x4*)(p.da_g + hh * 128 + dv0);
        u32x2 o;
        o[0] = pack_bf2(O[d][4 * i4] * rs * g[0], O[d][4 * i4 + 1] * rs * g[1]);
        o[1] = pack_bf2(O[d][4 * i4 + 2] * rs * g[2], O[d][4 * i4 + 3] * rs * g[3]);
        *(u32x2*)(dst + dv0) = o;
      }
  }
}

typedef __attribute__((address_space(1))) u32 gu32;
#define RLX_AGENT __ATOMIC_RELAXED, __HIP_MEMORY_SCOPE_AGENT
constexpr size_t ATT_SLOT = 34816;

DI void attn_chunk(const Params& p, int bb, int hh, int qt, int ktb, int kte, int ch, int nch, float lam, char* smem, int* s_flag) {
  const int tid = ltid(), lane = tid & 63, w = tid >> 6;
  f32x16 O[4];
  float m, l;
  attn_core(p, bb, hh, qt, ktb, kte, smem, O, m, l);
  l += __shfl_xor(l, 32);
  if (nch == 1) { attn_finish(p, bb, hh, qt, lam, smem, O, 1.f / l); return; }
  const float slope2 = exp2f(-2.f * (float)(hh + 1)) * LOG2E;
  const int uidx = ((bb * 2 + (hh - 2)) * 128 + qt) * 4;
  {
    char* slot = p.part + (size_t)(uidx + ch) * ATT_SLOT;
    gu32* po = (gu32*)((u32*)slot + (size_t)w * 32 * 64 + lane);
    const float invl = 1.f / l;
#pragma unroll
    for (int d = 0; d < 4; ++d)
#pragma unroll
      for (int k = 0; k < 8; ++k) __hip_atomic_store(po + (d * 8 + k) * 64, pack_h2(O[d][2 * k] * invl, O[d][2 * k + 1] * invl), RLX_AGENT);
    gu32* pm = (gu32*)((u32*)(slot + 32768) + w * 128 + lane);
    __hip_atomic_store(pm, __float_as_uint(m + slope2 * 64.f * (float)(kte - 1)), RLX_AGENT);
    __hip_atomic_store(pm + 64, __float_as_uint(l), RLX_AGENT);
  }
  asm volatile("s_waitcnt vmcnt(0)" ::: "memory");
  __syncthreads();
  if (tid == 0) *s_flag = (int)__hip_atomic_fetch_add(p.stats + 64 + ((bb * 4 + hh) * 128 + qt), 1u, RLX_AGENT);
  __syncthreads();
  if (*s_flag != nch - 1) return;
  float mc[4], lc[4];
  float M = -1e30f;
#pragma unroll
  for (int c = 0; c < 4; ++c) {
    mc[c] = -1e30f; lc[c] = 0.f;
    if (c < nch) {
      gu32* pm = (gu32*)((u32*)(p.part + (size_t)(uidx + c) * ATT_SLOT + 32768) + w * 128 + lane);
      mc[c] = __uint_as_float(__hip_atomic_load(pm, RLX_AGENT)); lc[c] = __uint_as_float(__hip_atomic_load(pm + 64, RLX_AGENT));
      M = fmaxf(M, mc[c]);
    }
  }
#pragma unroll
  for (int d = 0; d < 4; ++d)
#pragma unroll
    for (int i = 0; i < 16; ++i) O[d][i] = 0.f;
  float lsum = 0.f;
#pragma unroll
  for (int c = 0; c < 4; ++c) {
    if (c < nch) {
      const float wc = lc[c] * __builtin_amdgcn_exp2f(mc[c] - M);
      lsum += wc;
      gu32* po = (gu32*)((u32*)(p.part + (size_t)(uidx + c) * ATT_SLOT) + (size_t)w * 32 * 64 + lane);
#pragma unroll
      for (int d = 0; d < 4; ++d)
#pragma unroll
        for (int k = 0; k < 8; ++k) {
          const u32 v = __hip_atomic_load(po + (d * 8 + k) * 64, RLX_AGENT);
          const h2_t hv = __builtin_bit_cast(h2_t, v);
          O[d][2 * k] += wc * (float)hv[0];
          O[d][2 * k + 1] += wc * (float)hv[1];
        }
    }
  }
  attn_finish(p, bb, hh, qt, lam, smem, O, 1.f / lsum);
}

DI void phase2(const Params& p, char* smem) {
  __shared__ int s_unit;
  __shared__ int s_flag;
  float lam;
  {
    float a = 0.f, b = 0.f;
    for (int i = 0; i < 64; ++i) { a += p.lq1[i] * p.lk1[i]; b += p.lq2[i] * p.lk2[i]; }
    lam = expf(a) - expf(b) + 0.2f;
  }
  for (;;) {
    __syncthreads();
    if (threadIdx.x == 0) s_unit = (int)atomicAdd(p.stats + 32, 1u);
    __syncthreads();
    const int u = s_unit;
    if (u >= 128 * 20 + 512) break;
    if (u < 128 * 20) {
      const int qt = 127 - u / 20, sidx = u % 20, bb = sidx / 10, wq = sidx % 10;
      const int hh = wq < 2 ? wq : (wq < 6 ? 2 : 3);
      const int ch = wq < 2 ? 0 : ((wq - 2) & 3);
      const int bh = bb * 4 + hh;
      const float q0m = __uint_as_float(p.stats[bh * 2]), q1m = __uint_as_float(p.stats[bh * 2 + 1]);
      const float k0m = __uint_as_float(p.stats[16 + bh * 2]), k1m = __uint_as_float(p.stats[16 + bh * 2 + 1]);
      const float B = 1.02f * fmaxf(sqrtf(q0m * k0m), sqrtf(q1m * k1m));
      const float slope2 = exp2f(-2.f * (float)(hh + 1)) * LOG2E;
      const float span = ((2.f * B + 45.f) / slope2 + 63.f) * (1.f / 64.f);
      int kt0 = 0;
      if (span < 200.f) { kt0 = qt - (int)span; if (kt0 < 0) kt0 = 0; }
      const int n = qt - kt0 + 1;
      int nch = 1;
      if (hh >= 2) nch = n > 48 ? 4 : (n > 20 ? 2 : 1);
      if (ch < nch) {
        const int len = (n + nch - 1) / nch;
        const int ktb = kt0 + ch * len;
        int kte = ktb + len; if (kte > qt + 1) kte = qt + 1;
        if (ktb < kte) attn_chunk(p, bb, hh, qt, ktb, kte, ch, nch, lam, smem, &s_flag);
        else if (nch > 1) {
          if (threadIdx.x == 0) atomicAdd(p.stats + 64 + (bh * 128 + qt), 1u);
        }
      }
    } else {
      const int g = u - 128 * 20;
      gmlp_unit(p, g >> 2, g & 3, smem);
    }
  }
}

DI void phase3(const Params& p, char* smem) {
  const int lane = threadIdx.x & 63, w = threadIdx.x >> 6, wm = w >> 1, wn = w & 1, r = lane & 31, h = lane >> 5;
  for (int t = blockIdx.x; t < 128 * 8; t += gridDim.x) {
    const int m0 = (t >> 3) * 128, n0 = (t & 7) * 128;
    f32x16 acc[2][2];
#pragma unroll
    for (int a = 0; a < 2; ++a)
#pragma unroll
      for (int b = 0; b < 2; ++b)
#pragma unroll
        for (int i = 0; i < 16; ++i) acc[a][b][i] = 0.f;
    gemm_tile<2, 2, false>(p.mixcat + (size_t)m0 * 1024, 1024, p.w_oT + (size_t)n0 * 1024, 1024, 1024, acc, smem);
    float* sC = (float*)smem;
#pragma unroll
    for (int half = 0; half < 2; ++half) {
      __syncthreads();
      if (wm == half) {
#pragma unroll
        for (int a = 0; a < 2; ++a)
#pragma unroll
          for (int b = 0; b < 2; ++b)
#pragma unroll
            for (int i = 0; i < 16; ++i) sC[(a * 32 + crow(i, h)) * 132 + wn * 64 + b * 32 + r] = acc[a][b][i];
      }
      __syncthreads();
#pragma unroll
      for (int i = 0; i < 8; ++i) {
        const int idx = threadIdx.x + 256 * i, t = idx >> 5, c = idx & 31;
        const f32x4 mv = *(const f32x4*)(sC + t * 132 + c * 4);
        const size_t o = (size_t)(m0 + half * 64 + t) * 1024 + n0 + c * 4;
        const f32x4 xv = *(const f32x4*)(p.x + o);
        f32x4 y;
#pragma unroll
        for (int j = 0; j < 4; ++j) y[j] = ALPHA * xv[j] + mv[j];
        u32x2 hv; hv[0] = pack_h2(y[0], y[1]); hv[1] = pack_h2(y[2], y[3]);
        *(u32x2*)((u16*)p.y1 + o) = hv;
      }
    }
  }
}

DI void phase3b(const Params& p) {
  const int lane = threadIdx.x & 63;
  const int gw = blockIdx.x * 4 + (threadIdx.x >> 6), nw = gridDim.x * 4;
  const u16* y1h = (const u16*)p.y1;
  for (int row = gw; row < T_TOK; row += nw) {
    const size_t ro = (size_t)row * 1024;
    float v[16];
    float s = 0.f;
#pragma unroll
    for (int i = 0; i < 2; ++i) {
      const h8_t hv = __builtin_bit_cast(h8_t, *(const u32x4*)(y1h + ro + i * 512 + lane * 8));
#pragma unroll
      for (int c = 0; c < 8; ++c) { v[i * 8 + c] = (float)hv[c]; s += v[i * 8 + c]; }
    }
    s = wave_sum(s);
    const float mu = s * (1.f / 1024.f);
    float q = 0.f;
#pragma unroll
    for (int i = 0; i < 16; ++i) { const float d = v[i] - mu; q += d * d; }
    q = wave_sum(q);
    const float rs = rsqrtf(q * (1.f / 1024.f) + LN_EPS);
#pragma unroll
    for (int i = 0; i < 2; ++i) {
      const int col = i * 512 + lane * 8;
      const f32x4 g0 = *(const f32x4*)(p.ln1g + col), g1 = *(const f32x4*)(p.ln1g + col + 4);
      const f32x4 b0 = *(const f32x4*)(p.ln1b + col), b1 = *(const f32x4*)(p.ln1b + col + 4);
      float y[8];
#pragma unroll
      for (int c = 0; c < 4; ++c) { y[c] = (v[i * 8 + c] - mu) * rs * g0[c] + b0[c]; y[4 + c] = (v[i * 8 + 4 + c] - mu) * rs * g1[c] + b1[c]; }
      u32x4 hv;
#pragma unroll
      for (int c = 0; c < 4; ++c) hv[c] = pack_h2(y[2 * c], y[2 * c + 1]);
      *(u32x4*)(p.x1h + ro + col) = hv;
    }
  }
}

DI u32 f2key(float f) { const u32 u = __float_as_uint(f); return (u & 0x80000000u) ? ~u : (u | 0x80000000u); }
DI float key2f(u32 k) { return __uint_as_float((k & 0x80000000u) ? (k & 0x7fffffffu) : ~k); }
DI u32 umax(u32 a, u32 b) { return a > b ? a : b; }
DI u32 umin(u32 a, u32 b) { return a < b ? a : b; }

DI void sort16_desc(u32 (&v)[16]) {
#pragma unroll
  for (int k = 2; k <= 16; k <<= 1)
#pragma unroll
    for (int j = k >> 1; j > 0; j >>= 1)
#pragma unroll
      for (int i = 0; i < 16; ++i) {
        const int l = i ^ j;
        if (l > i) {
          const u32 hi = umax(v[i], v[l]), lo = umin(v[i], v[l]);
          if ((i & k) == 0) { v[i] = hi; v[l] = lo; } else { v[i] = lo; v[l] = hi; }
        }
      }
}
DI void merge16_desc(u32 (&a)[16], const u32 (&b)[16]) {
#pragma unroll
  for (int i = 0; i < 16; ++i) a[i] = umax(a[i], b[15 - i]);
#pragma unroll
  for (int j = 8; j > 0; j >>= 1)
#pragma unroll
    for (int i = 0; i < 16; ++i) {
      const int l = i ^ j;
      if (l > i) { const u32 hi = umax(a[i], a[l]), lo = umin(a[i], a[l]); a[i] = hi; a[l] = lo; }
    }
}

DI void peer_route_unit(const Params& p, int tb, int head, char* smem) {
  const int tid = threadIdx.x, lane = tid & 63, w = tid >> 6, r = lane & 31, h = lane >> 5;
  const int tok0 = tb * 128;
  u32 top[2][16];
  f32x16 sc8[8];
#pragma unroll
  for (int mt = 0; mt < 8; ++mt)
#pragma unroll
    for (int i = 0; i < 16; ++i) sc8[mt][i] = 0.f;
  gemm_tile_n8<true>(p.w_qT + (size_t)(head * 256) * 1024, 1024, p.x1h + (size_t)tok0 * 1024, 1024, 1024, sc8, smem);
#pragma unroll
  for (int half = 0; half < 2; ++half) {
    f32x16 (&sc)[4] = *(f32x16 (*)[4])(&sc8[half * 4]);
    u32 kv[4][16];
#pragma unroll
    for (int mt = 0; mt < 4; ++mt) {
#pragma unroll
      for (int i = 0; i < 16; ++i) {
        const int key = mt * 32 + crow(i, h);
        kv[mt][i] = (f2key(sc[mt][i]) & ~127u) | (u32)(127 - key);
      }
      sort16_desc(kv[mt]);
    }
    merge16_desc(kv[0], kv[1]);
    merge16_desc(kv[2], kv[3]);
    merge16_desc(kv[0], kv[2]);
    u32 other[16];
#pragma unroll
    for (int i = 0; i < 16; ++i) other[i] = (u32)__shfl_xor((int)kv[0][i], 32);
    merge16_desc(kv[0], other);
#pragma unroll
    for (int i = 0; i < 16; ++i) top[half][i] = kv[0][i];
  }
  __syncthreads();
  int* sIdx = (int*)smem;
  float va[16], vb[16];
#pragma unroll
  for (int i = 0; i < 16; ++i) {
    va[i] = key2f(top[0][i] & ~127u); vb[i] = key2f(top[1][i] & ~127u);
    sIdx[tid * 33 + i] = 127 - (int)(top[0][i] & 127u);
    sIdx[tid * 33 + 16 + i] = 127 - (int)(top[1][i] & 127u);
  }
  u32 cd[4][16];
  {
    u32 c[64];
    int n = 0;
#pragma unroll
    for (int i = 0; i < 16; ++i)
#pragma unroll
      for (int j = 0; j < 16; ++j)
        if ((i + 1) * (j + 1) <= 16) { c[n] = (f2key(va[i] + vb[j]) & ~255u) | (u32)(255 - (i * 16 + j)); ++n; }
#pragma unroll
    for (int q = 50; q < 64; ++q) c[q] = 0u;
#pragma unroll
    for (int g = 0; g < 4; ++g)
#pragma unroll
      for (int i = 0; i < 16; ++i) cd[g][i] = c[g * 16 + i];
  }
#pragma unroll
  for (int g = 0; g < 4; ++g) sort16_desc(cd[g]);
  merge16_desc(cd[0], cd[1]);
  merge16_desc(cd[2], cd[3]);
  merge16_desc(cd[0], cd[2]);
  float sv[16], sum = 0.f;
  const float mx = key2f(cd[0][0] & ~255u);
#pragma unroll
  for (int i = 0; i < 16; ++i) { sv[i] = __expf(key2f(cd[0][i] & ~255u) - mx); sum += sv[i]; }
  const float inv = 1.f / sum;
  if (h == 0) {
    const size_t o = (size_t)(tok0 + w * 32 + r) * 128 + head * 16;
#pragma unroll
    for (int q = 0; q < 4; ++q) {
      int e[4]; f32x4 g;
#pragma unroll
      for (int c = 0; c < 4; ++c) {
        const int code = 255 - (int)(cd[0][q * 4 + c] & 255u);
        const int ea = sIdx[tid * 33 + (code >> 4)], eb = sIdx[tid * 33 + 16 + (code & 15)];
        e[c] = ea * 128 + eb;
        g[c] = sv[q * 4 + c] * inv;
      }
      *(u32x4*)(p.eid + o + q * 4) = (u32x4){(u32)e[0], (u32)e[1], (u32)e[2], (u32)e[3]};
      *(f32x4*)(p.gate + o + q * 4) = g;
    }
  }
  __syncthreads();
}

DI void phase4(const Params& p, char* smem) {
  for (int u = blockIdx.x; u < 1024; u += gridDim.x) {
#pragma unroll 2
    for (int i = threadIdx.x; i < 2048; i += 256) {
      const size_t i8 = (size_t)u * 2048 + i;
      cvt8_fp8(p.pu, (unsigned char*)p.u16t, i8, 512.f);
      cvt8_fp8(p.pv, (unsigned char*)p.v16t, i8, 64.f);
    }
    peer_route_unit(p, u >> 3, u & 7, smem);
  }
}

template <int CTRL, int ROWMASK>
DI float dpp_f(float v) {
  return __int_as_float(__builtin_amdgcn_update_dpp(0, __float_as_int(v), CTRL, ROWMASK, 0xF, false));
}
DI float dpp_sum_uniform(float v) {
  v += dpp_f<0xB1, 0xF>(v);
  v += dpp_f<0x4E, 0xF>(v);
  v += dpp_f<0x141, 0xF>(v);
  v += dpp_f<0x140, 0xF>(v);
  v += dpp_f<0x142, 0xA>(v);
  v += dpp_f<0x143, 0xC>(v);
  return __int_as_float(__builtin_amdgcn_readlane(__float_as_int(v), 63));
}
DI void sort128(u32& a, u32& b, int lane) {
#pragma unroll
  for (int k = 2; k <= 128; k <<= 1) {
#pragma unroll
    for (int j = k >> 1; j > 0; j >>= 1) {
      const bool up = ((2 * lane) & k) == 0;
      if (j == 1) {
        const u32 lo = umin(a, b), hi = umax(a, b);
        a = up ? lo : hi; b = up ? hi : lo;
      } else {
        const int m = j >> 1;
        const u32 oa = (u32)__shfl_xor((int)a, m), ob = (u32)__shfl_xor((int)b, m);
        const bool lower = (lane & m) == 0;
        a = (lower == up) ? umin(a, oa) : umax(a, oa);
        b = (lower == up) ? umin(b, ob) : umax(b, ob);
      }
    }
  }
}

constexpr int P5T = 4;
struct BatchU { u32x4 ru[8]; };
struct BatchV { u32x4 rv[8]; u32 pe[8]; };
struct P5Tabs { __amdgpu_buffer_rsrc_t ur, vr; };

DI u32 p5_entry(const u32 (&v0)[P5T], const u32 (&v1)[P5T], int i, int j) {
  const int st = j >> 2, t = j & 3;
  return (u32)__builtin_amdgcn_readlane((int)(st ? v1[t] : v0[t]), i);
}
DI void p5_issue_u(const P5Tabs& tb_, BatchU& bu, const u32 (&v0)[P5T], const u32 (&v1)[P5T], int i, int loff) {
#pragma unroll
  for (int j = 0; j < 8; ++j) {
    const u32 pe = p5_entry(v0, v1, i, j);
    bu.ru[j] = __builtin_bit_cast(u32x4, __builtin_amdgcn_raw_buffer_load_b128(tb_.ur, loff, (int)((pe >> 18) << 10), 0));
  }
}
DI void p5_issue_v(const P5Tabs& tb_, BatchV& bv, const u32 (&v0)[P5T], const u32 (&v1)[P5T], int i, int loff) {
#pragma unroll
  for (int j = 0; j < 8; ++j) {
    const u32 pe = p5_entry(v0, v1, i, j);
    bv.pe[j] = pe;
    bv.rv[j] = __builtin_bit_cast(u32x4, __builtin_amdgcn_raw_buffer_load_b128(tb_.vr, loff, (int)((pe >> 18) << 10), 0));
  }
}

template <int CTRL>
DI float dppx(float v) { return __int_as_float(__builtin_amdgcn_update_dpp(0, __float_as_int(v), CTRL, 0xF, 0xF, false)); }

DI float p5_dots(const BatchU& bu, const u32 (&pe)[8], const h2_t (&xh)[P5T][8], int lane) {
  float dv[8];
#pragma unroll
  for (int j = 0; j < 8; ++j) {
    const int t = j & 3;
    float d0 = 0.f, d1 = 0.f;
#pragma unroll
    for (int i = 0; i < 4; ++i) {
      const h2_t c0 = __builtin_amdgcn_cvt_scalef32_pk_f16_fp8((int)bu.ru[j][i], 1.0f, false);
      const h2_t c1 = __builtin_amdgcn_cvt_scalef32_pk_f16_fp8((int)bu.ru[j][i], 1.0f, true);
      d0 = __builtin_amdgcn_fdot2(c0, xh[t][2 * i], d0, false);
      d1 = __builtin_amdgcn_fdot2(c1, xh[t][2 * i + 1], d1, false);
    }
    dv[j] = d0 + d1;
  }
  const bool b0 = lane & 1, b1 = lane & 2, b2 = lane & 4;
  float r[4];
#pragma unroll
  for (int k = 0; k < 4; ++k) {
    const float z0 = b0 ? dv[2 * k + 1] : dv[2 * k], z1 = b0 ? dv[2 * k] : dv[2 * k + 1];
    r[k] = z0 + dppx<0xB1>(z1);
  }
  float q[2];
#pragma unroll
  for (int k = 0; k < 2; ++k) {
    const float z0 = b1 ? r[2 * k + 1] : r[2 * k], z1 = b1 ? r[2 * k] : r[2 * k + 1];
    q[k] = z0 + dppx<0x4E>(z1);
  }
  float tt;
  {
    const float z0 = b2 ? q[1] : q[0], z1 = b2 ? q[0] : q[1];
    tt = z0 + __int_as_float(__builtin_amdgcn_ds_swizzle(__float_as_int(z1), 0x101F));
  }
  tt += dppx<0x128>(tt);
  tt += __int_as_float(__builtin_amdgcn_ds_swizzle(__float_as_int(tt), 0x401F));
  tt += __shfl_xor(tt, 32);
  int gi = 0;
#pragma unroll
  for (int j = 0; j < 8; ++j) {
    const int gv = __builtin_amdgcn_readfirstlane((int)(pe[j] & 0x3FFFFu));
    asm volatile("v_writelane_b32 %0, %1, %2" : "+v"(gi) : "s"(gv), "i"(j));
  }
  return (float)gi * (1.f / (262143.f * 64.f)) * gelu_fast(tt * (1.f / 512.f));
}
DI void p5_accum(const BatchV& bv, float wv, f2_t (&acc)[P5T][8]) {
#pragma unroll
  for (int j = 0; j < 8; ++j) {
    const int t = j & 3;
    const float wgt = __int_as_float(__builtin_amdgcn_readlane(__float_as_int(wv), j));
    const f2_t w2 = {wgt, wgt};
#pragma unroll
    for (int i = 0; i < 4; ++i) {
      const f2_t lo = __builtin_amdgcn_cvt_pk_f32_fp8((int)bv.rv[j][i], false);
      const f2_t hi = __builtin_amdgcn_cvt_pk_f32_fp8((int)bv.rv[j][i], true);
      acc[t][2 * i] = lo * w2 + acc[t][2 * i];
      acc[t][2 * i + 1] = hi * w2 + acc[t][2 * i + 1];
    }
  }
}

DI void phase5(const Params& p) {
  const int lane = threadIdx.x & 63;
  const int gw = blockIdx.x * 4 + (threadIdx.x >> 6), nw = gridDim.x * 4;
  P5Tabs tabs;
  tabs.ur = __builtin_amdgcn_make_buffer_rsrc((void*)p.u16t, 0, 16 << 20, 0x00020000);
  tabs.vr = __builtin_amdgcn_make_buffer_rsrc((void*)p.v16t, 0, 16 << 20, 0x00020000);
  for (int tb = gw * P5T; tb < T_TOK; tb += nw * P5T) {
    h2_t xh[P5T][8];
    u32 v0[P5T], v1[P5T];
    f2_t acc[P5T][8];
    int lp = lane;
    asm volatile("" : "+v"(lp));
#pragma unroll
    for (int t = 0; t < P5T; ++t) {
      const u32x4* xr = (const u32x4*)(p.x1h + (size_t)(tb + t) * 1024 + lp * 16);
      const h8_t xa = __builtin_bit_cast(h8_t, xr[0]), xb = __builtin_bit_cast(h8_t, xr[1]);
#pragma unroll
      for (int i = 0; i < 4; ++i) { xh[t][i] = (h2_t){xa[2 * i], xa[2 * i + 1]}; xh[t][4 + i] = (h2_t){xb[2 * i], xb[2 * i + 1]}; }
      const size_t eo = (size_t)(tb + t) * 128 + 2 * lp;
      const u32 ea = (u32)p.eid[eo], eb = (u32)p.eid[eo + 1];
      const float ga = p.gate[eo], gb = p.gate[eo + 1];
      u32 pa = (ea << 18) | (u32)(ga * 262143.f + 0.5f);
      u32 pb = (eb << 18) | (u32)(gb * 262143.f + 0.5f);
      sort128(pa, pb, lp);
      v0[t] = pa; v1[t] = pb;
#pragma unroll
      for (int i = 0; i < 8; ++i) acc[t][i] = (f2_t){0.f, 0.f};
    }
    BatchU U;
    BatchV V;
    const int rev = ((tb / (nw * P5T)) & 1) ? 63 : 0;
    p5_issue_u(tabs, U, v0, v1, rev, lane * 16);
    p5_issue_v(tabs, V, v0, v1, rev, lane * 16);
#pragma unroll 1
    for (int i = 0; i < 64; ++i) {
      const float wv = p5_dots(U, V.pe, xh, lane);
      if (i + 1 < 64) p5_issue_u(tabs, U, v0, v1, rev ^ (i + 1), lane * 16);
      p5_accum(V, wv, acc);
      if (i + 1 < 64) p5_issue_v(tabs, V, v0, v1, rev ^ (i + 1), lane * 16);
    }
    int le = lane;
    asm volatile("" : "+v"(le));
#pragma unroll
    for (int t = 0; t < P5T; ++t) {
      asm volatile("" ::: "memory");
      float y[16];
      float sm = 0.f;
#pragma unroll
      for (int e = 0; e < 16; ++e) {
        y[e] = ALPHA * (float)xh[t][e >> 1][e & 1] + acc[t][e >> 1][e & 1];
        sm += y[e];
      }
      sm = wave_sum(sm);
      const float mu = sm * (1.f / 1024.f);
      float qv = 0.f;
#pragma unroll
      for (int i = 0; i < 16; ++i) { const float dd = y[i] - mu; qv += dd * dd; }
      qv = wave_sum(qv);
      const float rsd = rsqrtf(qv * (1.f / 1024.f) + LN_EPS);
#pragma unroll
      for (int q = 0; q < 4; ++q) {
        const int col = le * 16 + q * 4;
        const f32x4 g = *(const f32x4*)(p.ln2g + col), be = *(const f32x4*)(p.ln2b + col);
        f32x4 o;
#pragma unroll
        for (int c = 0; c < 4; ++c) o[c] = (y[q * 4 + c] - mu) * rsd * g[c] + be[c];
        *(f32x4*)(p.out + (size_t)(tb + t) * 1024 + col) = o;
      }
    }
  }
}

#define XB_TMO      128
#define XB_XCNT(j)  (256  + 64 * (j))
#define XB_XSUB(j)  (1280 + 64 * (j))
#define XB_XGEN(j)  (2304 + 64 * (j))
#define XB_TOP      3328
#define XB_TOPGEN   3392
#define XCD_BAR_WORDS 3456
#define XB_SPIN_CAP (1u << 18)
#define LAS __attribute__((address_space(3)))
DI unsigned xb_ld(unsigned* p) { return __hip_atomic_load(p, __ATOMIC_RELAXED, __HIP_MEMORY_SCOPE_AGENT); }
DI unsigned xb_add(unsigned* p, unsigned v) { return __hip_atomic_fetch_add(p, v, __ATOMIC_RELAXED, __HIP_MEMORY_SCOPE_AGENT); }
DI unsigned xb_xcc_id() { return (unsigned)__builtin_amdgcn_s_getreg((3 << 11) | 20) & 0xFu; }
#define XB_SPIN(cond, bar) do { unsigned _sp = 0; while (cond) { __builtin_amdgcn_s_sleep(1); \
    if ((++_sp & 255u) == 0u) { if (xb_ld(&(bar)[XB_TMO])) break; if (_sp > XB_SPIN_CAP) { atomicAdd(&(bar)[XB_TMO], 1u); break; } } } } while (0)
struct XcdBarrier { unsigned* bar; unsigned x; volatile LAS unsigned* st; };
DI XcdBarrier xcd_barrier_post(unsigned* bar, volatile LAS unsigned* st) {
  XcdBarrier b; b.bar = bar; b.x = xb_xcc_id(); b.st = st;
  if (threadIdx.x == 0) (void)xb_add(&bar[XB_XCNT(b.x)], 1u);
  return b;
}
DI void xcd_barrier_complete(unsigned* bar, unsigned x, unsigned& nloc, unsigned& nx) {
  const unsigned G = gridDim.x * gridDim.y * gridDim.z;
  unsigned sum, cnt, mine, sp = 0u;
  for (;;) {
    sum = 0u; cnt = 0u; mine = 0u;
#pragma unroll
    for (unsigned j = 0; j < 16; ++j) { const unsigned c = xb_ld(&bar[XB_XCNT(j)]); sum += c; cnt += (c > 0u) ? 1u : 0u; mine = (j == x) ? c : mine; }
    if (sum == G) break;
    __builtin_amdgcn_s_sleep(1);
    if ((++sp & 255u) == 0u) { if (xb_ld(&bar[XB_TMO])) break; if (sp > XB_SPIN_CAP) { atomicAdd(&bar[XB_TMO], 1u); break; } }
  }
  nloc = mine > 0u ? mine : 1u; nx = cnt > 0u ? cnt : 1u;
}
DI void xcd_barrier(const XcdBarrier& b) {
  asm volatile("s_waitcnt vmcnt(0)" ::: "memory");
  __syncthreads();
  if (threadIdx.x == 0) {
    unsigned* bar = b.bar;
    __builtin_amdgcn_s_waitcnt(0);
    unsigned nloc = b.st[0], nx = b.st[1];
    if (nloc == 0u) { xcd_barrier_complete(bar, b.x, nloc, nx); b.st[0] = nloc; b.st[1] = nx; }
    const unsigned old = xb_add(&bar[XB_XSUB(b.x)], 1u);
    const unsigned gen = old / nloc;
    if (old + 1u == (gen + 1u) * nloc) {
      __builtin_amdgcn_fence(__ATOMIC_RELEASE, "agent");
      asm volatile("s_waitcnt vmcnt(0)" ::: "memory");
      const unsigned og = xb_add(&bar[XB_TOP], 1u);
      const unsigned tg = og / nx;
      if (og + 1u == (tg + 1u) * nx) xb_add(&bar[XB_TOPGEN], 1u);
      else XB_SPIN(xb_ld(&bar[XB_TOPGEN]) == tg, bar);
      __builtin_amdgcn_fence(__ATOMIC_ACQUIRE, "agent");
      xb_add(&bar[XB_XGEN(b.x)], 1u);
      asm volatile("s_waitcnt vmcnt(0)" ::: "memory");
    } else {
      XB_SPIN(xb_ld(&bar[XB_XGEN(b.x)]) == gen, bar);
      __builtin_amdgcn_fence(__ATOMIC_ACQUIRE, "agent");
      asm volatile("s_waitcnt vmcnt(0)" ::: "memory");
    }
  }
  __syncthreads();
}

__global__ void __launch_bounds__(256, 2) mega(Params p, int lo, int hi) {
  __shared__ __attribute__((aligned(16))) char smem[65536];
  __shared__ uint4 xb_words;
  cg::grid_group grid = cg::this_grid();
  if (lo > 1000) grid.sync();
  if (threadIdx.x == 0) xb_words = make_uint4(0u, 0u, 0u, 0u);
  __syncthreads();
  XcdBarrier xb = xcd_barrier_post(p.bar, (volatile LAS unsigned*)&xb_words);
#ifndef ONLY_PHASE
#define ONLY_PHASE -1
#endif
#define RUNPH(n) (lo <= n && n < hi && (ONLY_PHASE < 0 || ONLY_PHASE == n))
#define SYNCPH(n) if (lo <= n && n + 1 < hi) xcd_barrier(xb);
  if (RUNPH(0)) phase0(p, smem);
  SYNCPH(0)
  if (RUNPH(1)) phase1(p, smem);
  SYNCPH(1)
  if (RUNPH(2)) phase2(p, smem);
  SYNCPH(2)
  if (RUNPH(3)) phase3(p, smem);
  SYNCPH(3)
  if (RUNPH(3)) phase3b(p);
  SYNCPH(3)
  if (RUNPH(4)) phase4(p, smem);
  SYNCPH(4)
  if (RUNPH(5)) phase5(p);
}

extern "C" void kernel_launch(void* const* d_in, const int* in_sizes, int n_in, void* d_out, int out_size, void* d_ws,
                              size_t ws_size, hipStream_t stream) {
  Params p{};
  const float** f = (const float**)&p;
  for (int i = 0; i < 21; ++i) f[i] = (const float*)d_in[i];
  p.out = (float*)d_out;
  char* ws = (char*)d_ws;
  size_t off = 0;
  auto take = [&](size_t bytes) { char* r = ws + off; off += (bytes + 255) & ~(size_t)255; return r; };
  const size_t MB = 1u << 20;
  char* X = take(64 * MB);
  p.xb = (u16*)X; p.mixcat = p.xb;
  p.x1f = (float*)X;
  p.u16t = (u16*)take(16 * MB);
  p.v16t = (u16*)take(16 * MB);
  char* R = take(80 * MB);
  p.zu = (u16*)R; p.zvT = (u16*)(R + 16 * MB); p.qb = (u16*)(R + 32 * MB); p.kb = (u16*)(R + 48 * MB); p.vT = (u16*)(R + 64 * MB);
  p.y1 = (float*)R;
  p.w_inT = (u16*)take(5 * MB);
  p.w_oT = (u16*)take(2 * MB);
  p.w_qT = (u16*)take(4 * MB);
  p.keysh = (u16*)take(512 * 1024);
  p.wsb = (u16*)take(128 * 1024);
  p.bar = (unsigned*)take((XCD_BAR_WORDS + 64 + 1024) * 4);
  p.stats = p.bar + XCD_BAR_WORDS;
  p.lnst = (float*)take((size_t)T_TOK * 2 * 4);
  const size_t tail0 = off;
  p.x1h = (u16*)take(32 * MB);
  p.eid = (int*)take(8 * MB);
  p.gate = (float*)take(8 * MB);
  p.part = (char*)ws + tail0;
  if (tail0 + (size_t)2048 * ATT_SLOT > off) off = tail0 + (size_t)2048 * ATT_SLOT;
  if (off > ws_size) { fprintf(stderr, "workspace too small: need %zu have %zu\n", off, ws_size); return; }
  static int grid_blocks = 0;
  if (!grid_blocks) {
    int dev = 0, cus = 0, per_cu = 0;
    hipGetDevice(&dev);
    hipDeviceGetAttribute(&cus, hipDeviceAttributeMultiprocessorCount, dev);
    hipOccupancyMaxActiveBlocksPerMultiprocessor(&per_cu, mega, 256, 0);
    if (per_cu > 2) per_cu = 2;
    grid_blocks = cus * per_cu;
  }
  hipMemsetAsync(p.bar, 0, (XCD_BAR_WORDS + 64 + 1024) * 4, stream);
#ifdef MULTI_LAUNCH
  for (int ph = 0; ph < 6; ++ph) hipLaunchKernelGGL(mega, dim3(grid_blocks), dim3(256), 0, stream, p, ph, ph + 1);
#else
  int lo = 0, hi = 6;
  void* args[] = {&p, &lo, &hi};
  hipError_t e = hipLaunchCooperativeKernel((void*)mega, dim3(grid_blocks), dim3(256), args, 0, stream);
  if (e != hipSuccess) fprintf(stderr, "cooperative launch failed: %s (grid %d)\n", hipGetErrorString(e), grid_blocks);
#endif
}
```

```cpp
#include <hip/hip_runtime.h>
#include <hip/hip_cooperative_groups.h>
#include <cstdio>
namespace cg = cooperative_groups;

#define DI __device__ __forceinline__
typedef unsigned short u16;
typedef unsigned int u32;
typedef __attribute__((ext_vector_type(2))) __bf16 bf2_t;
typedef __attribute__((ext_vector_type(2))) float f2_t;
typedef __attribute__((ext_vector_type(2))) _Float16 h2_t;
typedef __attribute__((ext_vector_type(8))) _Float16 h8_t;
typedef __attribute__((ext_vector_type(8))) short s8_t;
typedef __attribute__((ext_vector_type(16))) float f32x16;
typedef __attribute__((ext_vector_type(4))) u32 u32x4;
typedef __attribute__((ext_vector_type(2))) u32 u32x2;
typedef __attribute__((ext_vector_type(4))) float f32x4;

constexpr int T_TOK = 16384;
constexpr int SEQ = 8192;
constexpr float ALPHA = 1.189207115002721f;
constexpr float LN_EPS = 1e-5f;
constexpr float LOG2E = 1.4426950408889634f;
#define LOG2E_C 1.4426950408889634f

struct Params {
  const float *x, *w_in, *gm_g, *gm_b, *gm_ws, *gm_bs, *lq1, *lk1, *lq2, *lk2, *da_g, *w_o, *ln1g, *ln1b,
      *w_q, *keys_a, *keys_b, *pu, *pv, *ln2g, *ln2b;
  float* out;
  u16 *xb, *mixcat, *u16t, *v16t, *zu, *zvT, *qb, *kb, *vT, *x1h, *w_inT, *w_oT, *w_qT, *keysh, *wsb;
  float* x1f;
  int* eid;
  float* gate;
  float* y1;
  unsigned* bar;
  float* lnst;
  char* part;
  unsigned* stats;
};

DI u32 pack_bf2(float a, float b) { f2_t v = {a, b}; bf2_t r = __builtin_convertvector(v, bf2_t); return __builtin_bit_cast(u32, r); }
DI u32 pack_h2(float a, float b) { f2_t v = {a, b}; h2_t r = __builtin_convertvector(v, h2_t); return __builtin_bit_cast(u32, r); }
DI float bf_lo(u32 u) { return __uint_as_float(u << 16); }
DI float bf_hi(u32 u) { return __uint_as_float(u & 0xffff0000u); }
DI float bf2f(u16 u) { return __uint_as_float(((u32)u) << 16); }
DI float gelu_f(float x) { return 0.5f * x * (1.f + erff(x * 0.70710678118654752f)); }
DI float gelu_fast(float x) {
  const float z = fabsf(x) * 0.70710678118654752f;
  const float t = __builtin_amdgcn_rcpf(1.f + 0.3275911f * z);
  const float poly = t * (0.254829592f + t * (-0.284496736f + t * (1.421413741f + t * (-1.453152027f + t * 1.061405429f))));
  const float e = poly * __builtin_amdgcn_exp2f(-z * z * LOG2E_C);
  const float erfabs = 1.f - e;
  const float erfv = x < 0.f ? -erfabs : erfabs;
  return 0.5f * x * (1.f + erfv);
}
DI float wave_sum(float v) {
#pragma unroll
  for (int o = 32; o > 0; o >>= 1) v += __shfl_xor(v, o);
  return v;
}
DI int ltid() { int t = threadIdx.x; asm volatile("" : "+v"(t)); return t; }
DI int crow(int i, int h) { return (i & 3) + 8 * (i >> 2) + 4 * h; }

template <bool F16>
DI f32x16 mfma32(u32x4 a, u32x4 b, f32x16 c) {
  if constexpr (F16)
    return __builtin_amdgcn_mfma_f32_32x32x16_f16(__builtin_bit_cast(h8_t, a), __builtin_bit_cast(h8_t, b), c, 0, 0, 0);
  else
    return __builtin_amdgcn_mfma_f32_32x32x16_bf16(__builtin_bit_cast(s8_t, a), __builtin_bit_cast(s8_t, b), c, 0, 0, 0);
}

template <int TM, int TN, bool F16>
DI void gemm_tile(const u16* __restrict__ A, int lda, const u16* __restrict__ B, int ldb, int K,
                  f32x16 (&acc)[TM][TN], char* smem) {
  static_assert(TM == 2 && TN == 2, "128x128 tile only");
  const int tid = ltid(), lane = tid & 63, w = tid >> 6, wm = w >> 1, wn = w & 1, r = lane & 31, h = lane >> 5;
  typedef __attribute__((address_space(1))) void gvoid;
  typedef __attribute__((address_space(3))) void lvoid;
  const u16* asrc[4];
  const u16* bsrc[4];
#pragma unroll
  for (int j = 0; j < 4; ++j) {
    const int row = (w * 4 + j) * 8 + (lane >> 3);
    const int c = (lane & 7) ^ ((row >> 1) & 7);
    asrc[j] = A + (size_t)row * lda + c * 8;
    bsrc[j] = B + (size_t)row * ldb + c * 8;
  }
  __syncthreads();
#pragma unroll
  for (int j = 0; j < 4; ++j) {
    __builtin_amdgcn_global_load_lds((const gvoid*)asrc[j], (lvoid*)(smem + (w * 4 + j) * 1024), 16, 0, 0);
    __builtin_amdgcn_global_load_lds((const gvoid*)bsrc[j], (lvoid*)(smem + 16384 + (w * 4 + j) * 1024), 16, 0, 0);
  }
  asm volatile("s_waitcnt vmcnt(0)" ::: "memory");
  __syncthreads();
  const int swz = (r >> 1) & 7;
  for (int k0 = 0; k0 < K; k0 += 64) {
    const char* buf = smem + ((k0 >> 6) & 1) * 32768;
    if (k0 + 64 < K) {
      char* nb = smem + (((k0 >> 6) + 1) & 1) * 32768;
#pragma unroll
      for (int j = 0; j < 4; ++j) {
        __builtin_amdgcn_global_load_lds((const gvoid*)(asrc[j] + k0 + 64), (lvoid*)(nb + (w * 4 + j) * 1024), 16, 0, 0);
        __builtin_amdgcn_global_load_lds((const gvoid*)(bsrc[j] + k0 + 64), (lvoid*)(nb + 16384 + (w * 4 + j) * 1024), 16, 0, 0);
      }
    }
#pragma unroll
    for (int ks = 0; ks < 4; ++ks) {
      u32x4 af[2], bfr[2];
      const int co = ((ks * 2 + h) ^ swz) << 4;
#pragma unroll
      for (int mt = 0; mt < 2; ++mt) af[mt] = *(const u32x4*)(buf + (wm * 64 + mt * 32 + r) * 128 + co);
#pragma unroll
      for (int nt = 0; nt < 2; ++nt) bfr[nt] = *(const u32x4*)(buf + 16384 + (wn * 64 + nt * 32 + r) * 128 + co);
#pragma unroll
      for (int mt = 0; mt < 2; ++mt)
#pragma unroll
        for (int nt = 0; nt < 2; ++nt) acc[mt][nt] = mfma32<F16>(af[mt], bfr[nt], acc[mt][nt]);
    }
    asm volatile("s_waitcnt vmcnt(0)" ::: "memory");
    __syncthreads();
  }
}

template <bool F16>
DI void gemm_tile_n4(const u16* __restrict__ A, int lda, const u16* __restrict__ B, int ldb, int K, f32x16 (&acc)[4], char* smem) {
  const int tid = ltid(), lane = tid & 63, w = tid >> 6, r = lane & 31, h = lane >> 5;
  typedef __attribute__((address_space(1))) void gvoid;
  typedef __attribute__((address_space(3))) void lvoid;
  const u16* asrc[4];
  const u16* bsrc[4];
#pragma unroll
  for (int j = 0; j < 4; ++j) {
    const int row = (w * 4 + j) * 8 + (lane >> 3);
    const int c = (lane & 7) ^ ((row >> 1) & 7);
    asrc[j] = A + (size_t)row * lda + c * 8;
    bsrc[j] = B + (size_t)row * ldb + c * 8;
  }
  __syncthreads();
#pragma unroll
  for (int j = 0; j < 4; ++j) {
    __builtin_amdgcn_global_load_lds((const gvoid*)asrc[j], (lvoid*)(smem + (w * 4 + j) * 1024), 16, 0, 0);
    __builtin_amdgcn_global_load_lds((const gvoid*)bsrc[j], (lvoid*)(smem + 16384 + (w * 4 + j) * 1024), 16, 0, 0);
  }
  asm volatile("s_waitcnt vmcnt(0)" ::: "memory");
  __syncthreads();
  const int swz = (r >> 1) & 7;
  for (int k0 = 0; k0 < K; k0 += 64) {
    const char* buf = smem + ((k0 >> 6) & 1) * 32768;
    if (k0 + 64 < K) {
      char* nb = smem + (((k0 >> 6) + 1) & 1) * 32768;
#pragma unroll
      for (int j = 0; j < 4; ++j) {
        __builtin_amdgcn_global_load_lds((const gvoid*)(asrc[j] + k0 + 64), (lvoid*)(nb + (w * 4 + j) * 1024), 16, 0, 0);
        __builtin_amdgcn_global_load_lds((const gvoid*)(bsrc[j] + k0 + 64), (lvoid*)(nb + 16384 + (w * 4 + j) * 1024), 16, 0, 0);
      }
    }
#pragma unroll
    for (int ks = 0; ks < 4; ++ks) {
      const int co = ((ks * 2 + h) ^ swz) << 4;
      const u32x4 bfr = *(const u32x4*)(buf + 16384 + (w * 32 + r) * 128 + co);
      u32x4 af[4];
#pragma unroll
      for (int mt = 0; mt < 4; ++mt) af[mt] = *(const u32x4*)(buf + (mt * 32 + r) * 128 + co);
#pragma unroll
      for (int mt = 0; mt < 4; ++mt) acc[mt] = mfma32<F16>(af[mt], bfr, acc[mt]);
    }
    asm volatile("s_waitcnt vmcnt(0)" ::: "memory");
    __syncthreads();
  }
}

template <bool F16>
DI void gemm_tile_n8(const u16* __restrict__ A, int lda, const u16* __restrict__ B, int ldb, int K, f32x16 (&acc)[8], char* smem) {
  const int tid = ltid(), lane = tid & 63, w = tid >> 6, r = lane & 31, h = lane >> 5;
  typedef __attribute__((address_space(1))) void gvoid;
  typedef __attribute__((address_space(3))) void lvoid;
  const u16* asrc[4];
  const u16* bsrc[2];
#pragma unroll
  for (int j = 0; j < 4; ++j) {
    const int row = (w * 4 + j) * 16 + (lane >> 2);
    asrc[j] = A + (size_t)row * lda + (((lane & 3) ^ ((row >> 2) & 3)) << 3);
  }
#pragma unroll
  for (int j = 0; j < 2; ++j) {
    const int row = (w * 2 + j) * 16 + (lane >> 2);
    bsrc[j] = B + (size_t)row * ldb + (((lane & 3) ^ ((row >> 2) & 3)) << 3);
  }
  __syncthreads();
#pragma unroll
  for (int j = 0; j < 4; ++j) __builtin_amdgcn_global_load_lds((const gvoid*)asrc[j], (lvoid*)(smem + (w * 4 + j) * 1024), 16, 0, 0);
#pragma unroll
  for (int j = 0; j < 2; ++j) __builtin_amdgcn_global_load_lds((const gvoid*)bsrc[j], (lvoid*)(smem + 16384 + (w * 2 + j) * 1024), 16, 0, 0);
  asm volatile("s_waitcnt vmcnt(0)" ::: "memory");
  __syncthreads();
  const int swz = (r >> 2) & 3;
  for (int k0 = 0; k0 < K; k0 += 32) {
    const char* buf = smem + ((k0 >> 5) & 1) * 24576;
    if (k0 + 32 < K) {
      char* nb = smem + (((k0 >> 5) + 1) & 1) * 24576;
#pragma unroll
      for (int j = 0; j < 4; ++j) __builtin_amdgcn_global_load_lds((const gvoid*)(asrc[j] + k0 + 32), (lvoid*)(nb + (w * 4 + j) * 1024), 16, 0, 0);
#pragma unroll
      for (int j = 0; j < 2; ++j) __builtin_amdgcn_global_load_lds((const gvoid*)(bsrc[j] + k0 + 32), (lvoid*)(nb + 16384 + (w * 2 + j) * 1024), 16, 0, 0);
    }
#pragma unroll
    for (int ks = 0; ks < 2; ++ks) {
      const int co = ((ks * 2 + h) ^ swz) << 4;
      const u32x4 bfr = *(const u32x4*)(buf + 16384 + (w * 32 + r) * 64 + co);
#pragma unroll
      for (int mt = 0; mt < 8; ++mt) {
        const u32x4 af = *(const u32x4*)(buf + (mt * 32 + r) * 64 + co);
        acc[mt] = mfma32<F16>(af, bfr, acc[mt]);
      }
    }
    asm volatile("s_waitcnt vmcnt(0)" ::: "memory");
    __syncthreads();
  }
}

DI void wk_tile(const Params& p, int hh16, int nt, char* smem) {
  const int tid = threadIdx.x, lane = tid & 63, w = tid >> 6, wm = w >> 1, wn = w & 1, r = lane & 31, h = lane >> 5;
  u16* sA = (u16*)smem;
  u16* sB = sA + 128 * 72;
  const float* ksrc = ((hh16 & 1) ? p.keys_b : p.keys_a) + (size_t)(hh16 >> 1) * 16384;
  const float* wsrc = p.w_q + (size_t)(nt * 128) * 2048 + hh16 * 128;
  f32x16 acc[2][2];
#pragma unroll
  for (int a = 0; a < 2; ++a)
#pragma unroll
    for (int b = 0; b < 2; ++b)
#pragma unroll
      for (int i = 0; i < 16; ++i) acc[a][b][i] = 0.f;
  for (int dh = 0; dh < 2; ++dh) {
    __syncthreads();
#pragma unroll
    for (int i = 0; i < 8; ++i) {
      const int idx = tid + 256 * i, row = idx >> 4, c4 = (idx & 15) * 4;
      const f32x4 kv = *(const f32x4*)(ksrc + row * 128 + dh * 64 + c4);
      const f32x4 wv = *(const f32x4*)(wsrc + (size_t)row * 2048 + dh * 64 + c4);
      *(u32x2*)(sA + row * 72 + c4) = (u32x2){pack_h2(kv[0], kv[1]), pack_h2(kv[2], kv[3])};
      *(u32x2*)(sB + row * 72 + c4) = (u32x2){pack_h2(wv[0], wv[1]), pack_h2(wv[2], wv[3])};
    }
    __syncthreads();
#pragma unroll
    for (int ks = 0; ks < 4; ++ks) {
      u32x4 af[2], bfr[2];
#pragma unroll
      for (int mt = 0; mt < 2; ++mt) af[mt] = *(const u32x4*)(sA + (wm * 64 + mt * 32 + r) * 72 + ks * 16 + 8 * h);
#pragma unroll
      for (int nt2 = 0; nt2 < 2; ++nt2) bfr[nt2] = *(const u32x4*)(sB + (wn * 64 + nt2 * 32 + r) * 72 + ks * 16 + 8 * h);
#pragma unroll
      for (int mt = 0; mt < 2; ++mt)
#pragma unroll
        for (int nt2 = 0; nt2 < 2; ++nt2) acc[mt][nt2] = mfma32<true>(af[mt], bfr[nt2], acc[mt][nt2]);
    }
  }
  u16* dst = p.w_qT + (size_t)hh16 * 128 * 1024 + nt * 128;
#pragma unroll
  for (int a = 0; a < 2; ++a)
#pragma unroll
    for (int b = 0; b < 2; ++b)
#pragma unroll
      for (int i = 0; i < 16; ++i)
        dst[(size_t)(wm * 64 + a * 32 + crow(i, h)) * 1024 + wn * 64 + b * 32 + r] = (u16)(pack_h2(acc[a][b][i], 0.f) & 0xffff);
}

template <bool F16>
DI void cvt8(const float* __restrict__ src, u16* __restrict__ dst, size_t i8) {
  const f32x4 a = *(const f32x4*)(src + i8 * 8), b = *(const f32x4*)(src + i8 * 8 + 4);
  u32x4 o;
  if constexpr (F16) { o[0] = pack_h2(a[0], a[1]); o[1] = pack_h2(a[2], a[3]); o[2] = pack_h2(b[0], b[1]); o[3] = pack_h2(b[2], b[3]); }
  else { o[0] = pack_bf2(a[0], a[1]); o[1] = pack_bf2(a[2], a[3]); o[2] = pack_bf2(b[0], b[1]); o[3] = pack_bf2(b[2], b[3]); }
  *(u32x4*)(dst + i8 * 8) = o;
}

DI void cvt8_fp8(const float* __restrict__ src, unsigned char* __restrict__ dst, size_t i8, float sc) {
  const f32x4 a = *(const f32x4*)(src + i8 * 8), b = *(const f32x4*)(src + i8 * 8 + 4);
  int w0 = 0, w1 = 0;
  w0 = __builtin_amdgcn_cvt_pk_fp8_f32(a[0] * sc, a[1] * sc, w0, false);
  w0 = __builtin_amdgcn_cvt_pk_fp8_f32(a[2] * sc, a[3] * sc, w0, true);
  w1 = __builtin_amdgcn_cvt_pk_fp8_f32(b[0] * sc, b[1] * sc, w1, false);
  w1 = __builtin_amdgcn_cvt_pk_fp8_f32(b[2] * sc, b[3] * sc, w1, true);
  *(u32x2*)(dst + i8 * 8) = (u32x2){(u32)w0, (u32)w1};
}

template <bool F16>
DI void transpose_tile(const float* __restrict__ W, int N, u16* __restrict__ WT, int kt, int nt, char* smem) {
  float* sT = (float*)smem;
  const int tid = threadIdx.x;
  __syncthreads();
#pragma unroll
  for (int i = 0; i < 4; ++i) {
    const int row = (tid >> 4) + 16 * i, c4 = (tid & 15) * 4;
    const f32x4 v = *(const f32x4*)(W + (size_t)(kt * 64 + row) * N + nt * 64 + c4);
    sT[row * 65 + c4 + 0] = v[0]; sT[row * 65 + c4 + 1] = v[1]; sT[row * 65 + c4 + 2] = v[2]; sT[row * 65 + c4 + 3] = v[3];
  }
  __syncthreads();
  const int n = tid >> 2, ks = (tid & 3) * 16;
  u32 o[8];
#pragma unroll
  for (int j = 0; j < 8; ++j) {
    const float a = sT[(ks + 2 * j) * 65 + n], b = sT[(ks + 2 * j + 1) * 65 + n];
    o[j] = F16 ? pack_h2(a, b) : pack_bf2(a, b);
  }
  u16* d = WT + (size_t)(nt * 64 + n) * 1024 + kt * 64 + ks;
  *(u32x4*)d = (u32x4){o[0], o[1], o[2], o[3]};
  *(u32x4*)(d + 8) = (u32x4){o[4], o[5], o[6], o[7]};
}

DI void phase0(const Params& p, char* smem) {
  const size_t gt = (size_t)blockIdx.x * 256 + threadIdx.x, gs = (size_t)gridDim.x * 256;
  for (size_t i = gt; i < (size_t)T_TOK * 1024 / 8; i += gs) cvt8<false>(p.x, p.xb, i);
  for (size_t i = gt; i < (size_t)T_TOK * 2; i += gs) p.lnst[i] = 0.f;
  for (size_t i = gt; i < 131072 / 8; i += gs) { cvt8<true>(p.keys_a, p.keysh, i); cvt8<true>(p.keys_b, p.keysh + 131072, i); }
  for (size_t i = gt; i < 65536; i += gs) {
    const int t = (i >> 7) & 127, s = i & 127;
    p.wsb[i] = (u16)(pack_bf2(s <= t ? p.gm_ws[i] : 0.f, 0.f) & 0xffff);
  }
  for (int t = blockIdx.x; t < 640 + 256 + 128; t += gridDim.x) {
    if (t < 640) transpose_tile<false>(p.w_in, 2560, p.w_inT, t / 40, t % 40, smem);
    else if (t < 896) transpose_tile<false>(p.w_o, 1024, p.w_oT, (t - 640) / 16, (t - 640) % 16, smem);
    else wk_tile(p, (t - 896) >> 3, (t - 896) & 7, smem);
  }
}

DI void phase1(const Params& p, char* smem) {
  const int lane = threadIdx.x & 63, w = threadIdx.x >> 6, wm = w >> 1, wn = w & 1, r = lane & 31, h = lane >> 5;
  for (int t = blockIdx.x; t < 128 * 20; t += gridDim.x) {
    const int mt_ = t / 20, nt_ = t % 20;
    const int m0 = mt_ * 128, n0 = nt_ * 128;
    const bool swapped = (n0 >= 512 && n0 < 1024) || (n0 >= 2048);
    f32x16 acc[2][2];
#pragma unroll
    for (int a = 0; a < 2; ++a)
#pragma unroll
      for (int b = 0; b < 2; ++b)
#pragma unroll
        for (int i = 0; i < 16; ++i) acc[a][b][i] = 0.f;
    if (!swapped) {
      gemm_tile<2, 2, false>(p.xb + (size_t)m0 * 1024, 1024, p.w_inT + (size_t)n0 * 1024, 1024, 1024, acc, smem);
      u16* dst; int cb; int mode;
      if (n0 < 512) { dst = p.zu; cb = n0; mode = 0; }
      else if (n0 < 1536) { dst = p.qb; cb = n0 - 1024; mode = 1; }
      else { dst = p.kb; cb = n0 - 1536; mode = 2; }
      float nmax = 0.f;
      u16* sC = (u16*)smem;
      __syncthreads();
#pragma unroll
      for (int a = 0; a < 2; ++a)
#pragma unroll
        for (int i = 0; i < 16; ++i) {
          float sq = 0.f;
#pragma unroll
          for (int b = 0; b < 2; ++b) {
            float v = acc[a][b][i];
            if (mode == 0) v = gelu_fast(v);
            else if (mode == 1) v *= 0.125f * LOG2E;
            const u32 pk = pack_bf2(v, 0.f);
            const float vr = bf_lo(pk);
            sq += vr * vr;
            sC[(wm * 64 + a * 32 + crow(i, h)) * 136 + wn * 64 + b * 32 + r] = (u16)(pk & 0xffff);
          }
          if (mode != 0) {
#pragma unroll
            for (int o = 1; o < 32; o <<= 1) sq += __shfl_xor(sq, o);
            nmax = fmaxf(nmax, sq);
          }
        }
      if (mode != 0) {
        nmax = fmaxf(nmax, __shfl_xor(nmax, 32));
        if (lane == 0) atomicMax(p.stats + (mode == 2 ? 16 : 0) + ((m0 >> 13) * 4 + (cb >> 7)) * 2 + wn, __float_as_uint(nmax));
      }
      __syncthreads();
#pragma unroll
      for (int i = 0; i < 8; ++i) {
        const int idx = threadIdx.x + 256 * i, t = idx >> 4, c = idx & 15;
        *(u32x4*)(dst + (size_t)(m0 + t) * 512 + cb + c * 8) = *(const u32x4*)(sC + t * 136 + c * 8);
      }
    } else {
      gemm_tile<2, 2, false>(p.w_inT + (size_t)n0 * 1024, 1024, p.xb + (size_t)m0 * 1024, 1024, 1024, acc, smem);
      const bool isz = n0 < 1024;
      u16* dst = isz ? p.zvT : p.vT;
      const int cb = isz ? n0 - 512 : n0 - 2048;
      const int bb = m0 >> 13, s0 = m0 & 8191;
      u16* sC = (u16*)smem;
      __syncthreads();
#pragma unroll
      for (int a = 0; a < 2; ++a)
#pragma unroll
        for (int b = 0; b < 2; ++b)
#pragma unroll
          for (int i = 0; i < 16; ++i) {
            float v = acc[a][b][i];
            if (isz) v = gelu_fast(v);
            const u32 pk = pack_bf2(v, 0.f);
            acc[a][b][i] = bf_lo(pk);
            sC[(wm * 64 + a * 32 + crow(i, h)) * 136 + wn * 64 + b * 32 + r] = (u16)(pk & 0xffff);
          }
      if (isz) {
#pragma unroll
        for (int b = 0; b < 2; ++b) {
          float sm = 0.f, sq = 0.f;
#pragma unroll
          for (int a = 0; a < 2; ++a)
#pragma unroll
            for (int i = 0; i < 16; ++i) { const float v = acc[a][b][i]; sm += v; sq += v * v; }
          sm += __shfl_xor(sm, 32); sq += __shfl_xor(sq, 32);
          if (h == 0) {
            float* st = p.lnst + (size_t)(m0 + wn * 64 + b * 32 + r) * 2;
            atomicAdd(st, sm); atomicAdd(st + 1, sq);
          }
        }
      }
      __syncthreads();
#pragma unroll
      for (int i = 0; i < 8; ++i) {
        const int idx = threadIdx.x + 256 * i, t = idx >> 4, c = idx & 15;
        *(u32x4*)(dst + ((size_t)bb * 512 + cb + t) * SEQ + s0 + c * 8) = *(const u32x4*)(sC + t * 136 + c * 8);
      }
    }
  }
}

DI void gmlp_unit(const Params& p, int chunk, int hh, char* smem) {
  const int tid = ltid(), lane = tid & 63, w = tid >> 6, wm = w >> 1, wn = w & 1, r = lane & 31, h = lane >> 5;
  const int tok0 = chunk * 128, bb = tok0 >> 13, s0 = tok0 & 8191;
  float* sMu = (float*)smem;
  float* sRs = sMu + 128;
  float* sPart = sRs + 128;
  u16* sA = (u16*)(smem + 17408);
  u16* sB = sA + 128 * 72;
  __syncthreads();
  if (tid < 128) {
    const float sa = p.lnst[(size_t)(tok0 + tid) * 2], sb = p.lnst[(size_t)(tok0 + tid) * 2 + 1];
    const float mu = sa * (1.f / 512.f);
    const float var = fmaxf(sb * (1.f / 512.f) - mu * mu, 0.f);
    sMu[tid] = mu; sRs[tid] = rsqrtf(var + LN_EPS);
  }
  f32x16 acc[2][2];
#pragma unroll
  for (int a = 0; a < 2; ++a)
#pragma unroll
    for (int b = 0; b < 2; ++b)
#pragma unroll
      for (int i = 0; i < 16; ++i) acc[a][b][i] = 0.f;
  for (int kh = 0; kh < 2; ++kh) {
    __syncthreads();
#pragma unroll
    for (int i = 0; i < 4; ++i) {
      const int idx = tid + 256 * i, row = idx >> 3, c = idx & 7;
      *(u32x4*)(sA + row * 72 + c * 8) = *(const u32x4*)(p.wsb + (size_t)hh * 16384 + row * 128 + kh * 64 + c * 8);
      const int ch = hh * 128 + row;
      const u32x4 v = *(const u32x4*)(p.zvT + ((size_t)bb * 512 + ch) * SEQ + s0 + kh * 64 + c * 8);
      const float g = p.gm_g[ch], be = p.gm_b[ch];
      u32x4 o;
#pragma unroll
      for (int j = 0; j < 4; ++j) {
        const int s = kh * 64 + c * 8 + 2 * j;
        const float a = (bf_lo(v[j]) - sMu[s]) * sRs[s] * g + be;
        const float b = (bf_hi(v[j]) - sMu[s + 1]) * sRs[s + 1] * g + be;
        o[j] = pack_bf2(a, b);
      }
      *(u32x4*)(sB + row * 72 + c * 8) = o;
    }
    __syncthreads();
#pragma unroll
    for (int ks = 0; ks < 4; ++ks) {
      u32x4 af[2], bfr[2];
#pragma unroll
      for (int mt = 0; mt < 2; ++mt) af[mt] = *(const u32x4*)(sA + (wm * 64 + mt * 32 + r) * 72 + ks * 16 + 8 * h);
#pragma unroll
      for (int nt = 0; nt < 2; ++nt) bfr[nt] = *(const u32x4*)(sB + (wn * 64 + nt * 32 + r) * 72 + ks * 16 + 8 * h);
#pragma unroll
      for (int mt = 0; mt < 2; ++mt)
#pragma unroll
        for (int nt = 0; nt < 2; ++nt) acc[mt][nt] = mfma32<false>(af[mt], bfr[nt], acc[mt][nt]);
    }
  }
  __syncthreads();
  {
    u16* sC = (u16*)smem;
#pragma unroll
    for (int a = 0; a < 2; ++a)
#pragma unroll
      for (int i = 0; i < 16; ++i) {
        const int t = wm * 64 + a * 32 + crow(i, h);
        const float bs = p.gm_bs[hh * 128 + t];
#pragma unroll
        for (int b = 0; b < 2; ++b) sC[t * 136 + wn * 64 + b * 32 + r] = (u16)(pack_bf2(acc[a][b][i] + bs, 0.f) & 0xffff);
      }
    __syncthreads();
#pragma unroll
    for (int i = 0; i < 8; ++i) {
      const int idx = tid + 256 * i, t = idx >> 4, c = idx & 15;
      const u32x4 mv = *(const u32x4*)(sC + t * 136 + c * 8);
      const u32x4 uv = *(const u32x4*)(p.zu + (size_t)(tok0 + t) * 512 + hh * 128 + c * 8);
      u32x4 o;
#pragma unroll
      for (int j = 0; j < 4; ++j) o[j] = pack_bf2(bf_lo(mv[j]) * bf_lo(uv[j]), bf_hi(mv[j]) * bf_hi(uv[j]));
      *(u32x4*)(p.mixcat + (size_t)(tok0 + t) * 1024 + hh * 128 + c * 8) = o;
    }
  }
}

DI void attn_core(const Params& p, int bb, int hh, int qt, int ktb, int kte, char* smem, f32x16 (&O)[4], float& m_out, float& l_out) {
  const int tid = ltid(), lane = tid & 63, w = tid >> 6, r = lane & 31, h = lane >> 5;
  const int map = w >> 1, qs = w & 1;
  const size_t tok0 = (size_t)bb * SEQ;
  const int q0 = qt * 64;
  const float slope2 = exp2f(-2.f * (float)(hh + 1)) * LOG2E;
  u32x4 qf[4];
  {
    const u16* qptr = p.qb + (tok0 + q0 + qs * 32 + r) * 512 + hh * 128 + map * 64 + 8 * h;
#pragma unroll
    for (int ks = 0; ks < 4; ++ks) qf[ks] = *(const u32x4*)(qptr + ks * 16);
  }
#pragma unroll
  for (int d = 0; d < 4; ++d)
#pragma unroll
    for (int i = 0; i < 16; ++i) O[d][i] = 0.f;
  float m = -1e30f, l = 0.f;
  const u16* kbase = p.kb + tok0 * 512 + hh * 128;
  const u16* vbase = p.vT + (size_t)(bb * 4 + hh) * 128 * SEQ;
  u32 koff[4], voff[4];
#pragma unroll
  for (int j = 0; j < 4; ++j) {
    const int krow = (w * 4 + j) * 4 + (lane >> 4);
    koff[j] = (u32)(krow * 512 + (((lane & 15) ^ (krow & 15)) << 3));
    const int vrow = (w * 4 + j) * 8 + (lane >> 3);
    voff[j] = (u32)(vrow * SEQ + (((lane & 7) ^ ((vrow >> 1) & 7)) << 3));
  }
  const int kr = (r & ~12) | ((r & 4) << 1) | ((r & 8) >> 1);
  const float hb = slope2 * (float)(8 * h);
  typedef __attribute__((address_space(1))) void gvoid;
  typedef __attribute__((address_space(3))) void lvoid;
  __syncthreads();
  {
    char* buf = smem + (ktb & 1) * 32768;
#pragma unroll
    for (int j = 0; j < 4; ++j) {
      __builtin_amdgcn_global_load_lds((const gvoid*)(kbase + (size_t)ktb * 64 * 512 + koff[j]), (lvoid*)(buf + (w * 4 + j) * 1024), 16, 0, 0);
      __builtin_amdgcn_global_load_lds((const gvoid*)(vbase + (size_t)ktb * 64 + voff[j]), (lvoid*)(buf + 16384 + (w * 4 + j) * 1024), 16, 0, 0);
    }
  }
  asm volatile("s_waitcnt vmcnt(0)" ::: "memory");
  __syncthreads();
  for (int kt = ktb; kt < kte; ++kt) {
    const char* buf = smem + (kt & 1) * 32768;
    if (kt + 1 < kte) {
      char* nb = smem + ((kt + 1) & 1) * 32768;
#pragma unroll
      for (int j = 0; j < 4; ++j) {
        __builtin_amdgcn_global_load_lds((const gvoid*)(kbase + (size_t)(kt + 1) * 64 * 512 + koff[j]), (lvoid*)(nb + (w * 4 + j) * 1024), 16, 0, 0);
        __builtin_amdgcn_global_load_lds((const gvoid*)(vbase + (size_t)(kt + 1) * 64 + voff[j]), (lvoid*)(nb + 16384 + (w * 4 + j) * 1024), 16, 0, 0);
      }
    }
    f32x16 S[2];
    {
      float hb2 = hb, sl = slope2;
      asm volatile("" : "+v"(hb2), "+v"(sl));
#pragma unroll
      for (int mt = 0; mt < 2; ++mt)
#pragma unroll
        for (int i = 0; i < 16; ++i) {
          if ((i & 7) == 0) S[mt][i] = hb2 + sl * (float)(32 * mt + 16 * (i >> 3));
          else S[mt][i] = S[mt][i - 1] + sl;
        }
    }
#pragma unroll
    for (int mt = 0; mt < 2; ++mt) {
      u32x4 af[4];
#pragma unroll
      for (int ks = 0; ks < 4; ++ks)
        af[ks] = *(const u32x4*)(buf + (mt * 32 + kr) * 256 + (((map * 8 + ks * 2 + h) ^ (kr & 15)) << 4));
#pragma unroll
      for (int ks = 0; ks < 4; ++ks) S[mt] = mfma32<false>(af[ks], qf[ks], S[mt]);
    }
    if (kt > ktb) m -= slope2 * 64.f;
    if (kt == qt) {
      const int qrel = qs * 32 + r;
#pragma unroll
      for (int mt = 0; mt < 2; ++mt)
#pragma unroll
        for (int i = 0; i < 16; ++i) {
          const int keyrel = 32 * mt + 16 * (i >> 3) + 8 * h + (i & 7);
          if (keyrel > qrel) S[mt][i] = -1e30f;
        }
    }
    float mx = S[0][0];
#pragma unroll
    for (int i = 1; i < 16; ++i) mx = fmaxf(mx, S[0][i]);
#pragma unroll
    for (int i = 0; i < 16; ++i) mx = fmaxf(mx, S[1][i]);
    mx = fmaxf(mx, __shfl_xor(mx, 32));
    if (__any(mx > m + 8.f)) {
      const float mn = fmaxf(m, mx);
      const float alpha = __builtin_amdgcn_exp2f(m - mn);
      m = mn;
      l *= alpha;
#pragma unroll
      for (int d = 0; d < 4; ++d)
#pragma unroll
        for (int i = 0; i < 16; ++i) O[d][i] *= alpha;
    }
    float ls = 0.f;
#pragma unroll
    for (int mt = 0; mt < 2; ++mt)
#pragma unroll
      for (int i = 0; i < 16; ++i) { const float e = __builtin_amdgcn_exp2f(S[mt][i] - m); S[mt][i] = e; ls += e; }
    l += ls;
#pragma unroll
    for (int mt = 0; mt < 2; ++mt)
#pragma unroll
      for (int s2 = 0; s2 < 2; ++s2) {
        u32x4 pf;
#pragma unroll
        for (int j = 0; j < 4; ++j) pf[j] = pack_bf2(S[mt][8 * s2 + 2 * j], S[mt][8 * s2 + 2 * j + 1]);
        u32x4 vf[4];
#pragma unroll
        for (int d = 0; d < 4; ++d)
          vf[d] = *(const u32x4*)(buf + 16384 + (d * 32 + r) * 128 + (((mt * 4 + s2 * 2 + h) ^ ((r >> 1) & 7)) << 4));
#pragma unroll
        for (int d = 0; d < 4; ++d) O[d] = mfma32<false>(vf[d], pf, O[d]);
      }
    asm volatile("s_waitcnt vmcnt(0)" ::: "memory");
    __syncthreads();
  }
  m_out = m; l_out = l;
}

DI void attn_finish(const Params& p, int bb, int hh, int qt, float lam, char* smem, f32x16 (&O)[4], float inv) {
  const int tid = ltid(), lane = tid & 63, w = tid >> 6, r = lane & 31, h = lane >> 5;
  const int map = w >> 1, qs = w & 1;
  const size_t tok0 = (size_t)bb * SEQ;
  const int q0 = qt * 64;
  __syncthreads();
  float* sC = (float*)smem;
  if (map == 1) {
    const float sc = inv * lam;
#pragma unroll
    for (int d = 0; d < 4; ++d)
#pragma unroll
      for (int i = 0; i < 16; ++i) sC[(qs * 64 + d * 16 + i) * 64 + lane] = O[d][i] * sc;
  }
  __syncthreads();
  if (map == 0) {
    float ss = 0.f;
#pragma unroll
    for (int d = 0; d < 4; ++d)
#pragma unroll
      for (int i = 0; i < 16; ++i) {
        const float v = O[d][i] * inv - sC[(qs * 64 + d * 16 + i) * 64 + lane];
        O[d][i] = v; ss += v * v;
      }
    ss += __shfl_xor(ss, 32);
    const float rs = rsqrtf(ss * (1.f / 128.f) + LN_EPS) * 0.8f;
    u16* dst = p.mixcat + (tok0 + q0 + qs * 32 + r) * 1024 + 512 + hh * 128;
#pragma unroll
    for (int d = 0; d < 4; ++d)
#pragma unroll
      for (int i4 = 0; i4 < 4; ++i4) {
        const int dv0 = d * 32 + 8 * i4 + 4 * h;
        const f32x4 g = *(const f32x4*)(p.da_g + hh * 128 + dv0);
        u32x2 o;
        o[0] = pack_bf2(O[d][4 * i4] * rs * g[0], O[d][4 * i4 + 1] * rs * g[1]);
        o[1] = pack_bf2(O[d][4 * i4 + 2] * rs * g[2], O[d][4 * i4 + 3] * rs * g[3]);
        *(u32x2*)(dst + dv0) = o;
      }
  }
}

typedef __attribute__((address_space(1))) u32 gu32;
#define RLX_AGENT __ATOMIC_RELAXED, __HIP_MEMORY_SCOPE_AGENT
constexpr size_t ATT_SLOT = 34816;

DI void attn_chunk(const Params& p, int bb, int hh, int qt, int ktb, int kte, int ch, int nch, float lam, char* smem, int* s_flag) {
  const int tid = ltid(), lane = tid & 63, w = tid >> 6;
  f32x16 O[4];
  float m, l;
  attn_core(p, bb, hh, qt, ktb, kte, smem, O, m, l);
  l += __shfl_xor(l, 32);
  if (nch == 1) { attn_finish(p, bb, hh, qt, lam, smem, O, 1.f / l); return; }
  const float slope2 = exp2f(-2.f * (float)(hh + 1)) * LOG2E;
  const int uidx = ((bb * 2 + (hh - 2)) * 128 + qt) * 4;
  {
    char* slot = p.part + (size_t)(uidx + ch) * ATT_SLOT;
    gu32* po = (gu32*)((u32*)slot + (size_t)w * 32 * 64 + lane);
    const float invl = 1.f / l;
#pragma unroll
    for (int d = 0; d < 4; ++d)
#pragma unroll
      for (int k = 0; k < 8; ++k) __hip_atomic_store(po + (d * 8 + k) * 64, pack_h2(O[d][2 * k] * invl, O[d][2 * k + 1] * invl), RLX_AGENT);
    gu32* pm = (gu32*)((u32*)(slot + 32768) + w * 128 + lane);
    __hip_atomic_store(pm, __float_as_uint(m + slope2 * 64.f * (float)(kte - 1)), RLX_AGENT);
    __hip_atomic_store(pm + 64, __float_as_uint(l), RLX_AGENT);
  }
  asm volatile("s_waitcnt vmcnt(0)" ::: "memory");
  __syncthreads();
  if (tid == 0) *s_flag = (int)__hip_atomic_fetch_add(p.stats + 64 + ((bb * 4 + hh) * 128 + qt), 1u, RLX_AGENT);
  __syncthreads();
  if (*s_flag != nch - 1) return;
  float mc[4], lc[4];
  float M = -1e30f;
#pragma unroll
  for (int c = 0; c < 4; ++c) {
    mc[c] = -1e30f; lc[c] = 0.f;
    if (c < nch) {
      gu32* pm = (gu32*)((u32*)(p.part + (size_t)(uidx + c) * ATT_SLOT + 32768) + w * 128 + lane);
      mc[c] = __uint_as_float(__hip_atomic_load(pm, RLX_AGENT)); lc[c] = __uint_as_float(__hip_atomic_load(pm + 64, RLX_AGENT));
      M = fmaxf(M, mc[c]);
    }
  }
#pragma unroll
  for (int d = 0; d < 4; ++d)
#pragma unroll
    for (int i = 0; i < 16; ++i) O[d][i] = 0.f;
  float lsum = 0.f;
#pragma unroll
  for (int c = 0; c < 4; ++c) {
    if (c < nch) {
      const float wc = lc[c] * __builtin_amdgcn_exp2f(mc[c] - M);
      lsum += wc;
      gu32* po = (gu32*)((u32*)(p.part + (size_t)(uidx + c) * ATT_SLOT) + (size_t)w * 32 * 64 + lane);
#pragma unroll
      for (int d = 0; d < 4; ++d)
#pragma unroll
        for (int k = 0; k < 8; ++k) {
          const u32 v = __hip_atomic_load(po + (d * 8 + k) * 64, RLX_AGENT);
          const h2_t hv = __builtin_bit_cast(h2_t, v);
          O[d][2 * k] += wc * (float)hv[0];
          O[d][2 * k + 1] += wc * (float)hv[1];
        }
    }
  }
  attn_finish(p, bb, hh, qt, lam, smem, O, 1.f / lsum);
}

DI void phase2(const Params& p, char* smem) {
  __shared__ int s_unit;
  __shared__ int s_flag;
  float lam;
  {
    float a = 0.f, b = 0.f;
    for (int i = 0; i < 64; ++i) { a += p.lq1[i] * p.lk1[i]; b += p.lq2[i] * p.lk2[i]; }
    lam = expf(a) - expf(b) + 0.2f;
  }
  for (;;) {
    __syncthreads();
    if (threadIdx.x == 0) s_unit = (int)atomicAdd(p.stats + 32, 1u);
    __syncthreads();
    const int u = s_unit;
    if (u >= 128 * 20 + 512) break;
    if (u < 128 * 20) {
      const int qt = 127 - u / 20, sidx = u % 20, bb = sidx / 10, wq = sidx % 10;
      const int hh = wq < 2 ? wq : (wq < 6 ? 2 : 3);
      const int ch = wq < 2 ? 0 : ((wq - 2) & 3);
      const int bh = bb * 4 + hh;
      const float q0m = __uint_as_float(p.stats[bh * 2]), q1m = __uint_as_float(p.stats[bh * 2 + 1]);
      const float k0m = __uint_as_float(p.stats[16 + bh * 2]), k1m = __uint_as_float(p.stats[16 + bh * 2 + 1]);
      const float B = 1.02f * fmaxf(sqrtf(q0m * k0m), sqrtf(q1m * k1m));
      const float slope2 = exp2f(-2.f * (float)(hh + 1)) * LOG2E;
      const float span = ((2.f * B + 45.f) / slope2 + 63.f) * (1.f / 64.f);
      int kt0 = 0;
      if (span < 200.f) { kt0 = qt - (int)span; if (kt0 < 0) kt0 = 0; }
      const int n = qt - kt0 + 1;
      int nch = 1;
      if (hh >= 2) nch = n > 48 ? 4 : (n > 20 ? 2 : 1);
      if (ch < nch) {
        const int len = (n + nch - 1) / nch;
        const int ktb = kt0 + ch * len;
        int kte = ktb + len; if (kte > qt + 1) kte = qt + 1;
        if (ktb < kte) attn_chunk(p, bb, hh, qt, ktb, kte, ch, nch, lam, smem, &s_flag);
        else if (nch > 1) {
          if (threadIdx.x == 0) atomicAdd(p.stats + 64 + (bh * 128 + qt), 1u);
        }
      }
    } else {
      const int g = u - 128 * 20;
      gmlp_unit(p, g >> 2, g & 3, smem);
    }
  }
}

DI void phase3(const Params& p, char* smem) {
  const int lane = threadIdx.x & 63, w = threadIdx.x >> 6, wm = w >> 1, wn = w & 1, r = lane & 31, h = lane >> 5;
  for (int t = blockIdx.x; t < 128 * 8; t += gridDim.x) {
    const int m0 = (t >> 3) * 128, n0 = (t & 7) * 128;
    f32x16 acc[2][2];
#pragma unroll
    for (int a = 0; a < 2; ++a)
#pragma unroll
      for (int b = 0; b < 2; ++b)
#pragma unroll
        for (int i = 0; i < 16; ++i) acc[a][b][i] = 0.f;
    gemm_tile<2, 2, false>(p.mixcat + (size_t)m0 * 1024, 1024, p.w_oT + (size_t)n0 * 1024, 1024, 1024, acc, smem);
    float* sC = (float*)smem;
#pragma unroll
    for (int half = 0; half < 2; ++half) {
      __syncthreads();
      if (wm == half) {
#pragma unroll
        for (int a = 0; a < 2; ++a)
#pragma unroll
          for (int b = 0; b < 2; ++b)
#pragma unroll
            for (int i = 0; i < 16; ++i) sC[(a * 32 + crow(i, h)) * 132 + wn * 64 + b * 32 + r] = acc[a][b][i];
      }
      __syncthreads();
#pragma unroll
      for (int i = 0; i < 8; ++i) {
        const int idx = threadIdx.x + 256 * i, t = idx >> 5, c = idx & 31;
        const f32x4 mv = *(const f32x4*)(sC + t * 132 + c * 4);
        const size_t o = (size_t)(m0 + half * 64 + t) * 1024 + n0 + c * 4;
        const u32x2 xq = *(const u32x2*)(p.xb + o);
        const float xv[4] = {bf_lo(xq[0]), bf_hi(xq[0]), bf_lo(xq[1]), bf_hi(xq[1])};
        f32x4 y;
#pragma unroll
        for (int j = 0; j < 4; ++j) y[j] = ALPHA * xv[j] + mv[j];
        u32x2 hv; hv[0] = pack_h2(y[0], y[1]); hv[1] = pack_h2(y[2], y[3]);
        *(u32x2*)((u16*)p.y1 + o) = hv;
      }
    }
  }
}

DI void phase3b(const Params& p) {
  const int lane = threadIdx.x & 63;
  const int gw = blockIdx.x * 4 + (threadIdx.x >> 6), nw = gridDim.x * 4;
  const u16* y1h = (const u16*)p.y1;
  for (int row = gw; row < T_TOK; row += nw) {
    const size_t ro = (size_t)row * 1024;
    float v[16];
    float s = 0.f;
#pragma unroll
    for (int i = 0; i < 2; ++i) {
      const h8_t hv = __builtin_bit_cast(h8_t, *(const u32x4*)(y1h + ro + i * 512 + lane * 8));
#pragma unroll
      for (int c = 0; c < 8; ++c) { v[i * 8 + c] = (float)hv[c]; s += v[i * 8 + c]; }
    }
    s = wave_sum(s);
    const float mu = s * (1.f / 1024.f);
    float q = 0.f;
#pragma unroll
    for (int i = 0; i < 16; ++i) { const float d = v[i] - mu; q += d * d; }
    q = wave_sum(q);
    const float rs = rsqrtf(q * (1.f / 1024.f) + LN_EPS);
#pragma unroll
    for (int i = 0; i < 2; ++i) {
      const int col = i * 512 + lane * 8;
      const f32x4 g0 = *(const f32x4*)(p.ln1g + col), g1 = *(const f32x4*)(p.ln1g + col + 4);
      const f32x4 b0 = *(const f32x4*)(p.ln1b + col), b1 = *(const f32x4*)(p.ln1b + col + 4);
      float y[8];
#pragma unroll
      for (int c = 0; c < 4; ++c) { y[c] = (v[i * 8 + c] - mu) * rs * g0[c] + b0[c]; y[4 + c] = (v[i * 8 + 4 + c] - mu) * rs * g1[c] + b1[c]; }
      u32x4 hv;
#pragma unroll
      for (int c = 0; c < 4; ++c) hv[c] = pack_h2(y[2 * c], y[2 * c + 1]);
      *(u32x4*)(p.x1h + ro + col) = hv;
    }
  }
}

DI u32 f2key(float f) { const u32 u = __float_as_uint(f); return (u & 0x80000000u) ? ~u : (u | 0x80000000u); }
DI float key2f(u32 k) { return __uint_as_float((k & 0x80000000u) ? (k & 0x7fffffffu) : ~k); }
DI u32 umax(u32 a, u32 b) { return a > b ? a : b; }
DI u32 umin(u32 a, u32 b) { return a < b ? a : b; }

DI void sort16_desc(u32 (&v)[16]) {
#pragma unroll
  for (int k = 2; k <= 16; k <<= 1)
#pragma unroll
    for (int j = k >> 1; j > 0; j >>= 1)
#pragma unroll
      for (int i = 0; i < 16; ++i) {
        const int l = i ^ j;
        if (l > i) {
          const u32 hi = umax(v[i], v[l]), lo = umin(v[i], v[l]);
          if ((i & k) == 0) { v[i] = hi; v[l] = lo; } else { v[i] = lo; v[l] = hi; }
        }
      }
}
DI void merge16_desc(u32 (&a)[16], const u32 (&b)[16]) {
#pragma unroll
  for (int i = 0; i < 16; ++i) a[i] = umax(a[i], b[15 - i]);
#pragma unroll
  for (int j = 8; j > 0; j >>= 1)
#pragma unroll
    for (int i = 0; i < 16; ++i) {
      const int l = i ^ j;
      if (l > i) { const u32 hi = umax(a[i], a[l]), lo = umin(a[i], a[l]); a[i] = hi; a[l] = lo; }
    }
}

DI void peer_route_unit(const Params& p, int tb, int head, char* smem) {
  const int tid = threadIdx.x, lane = tid & 63, w = tid >> 6, r = lane & 31, h = lane >> 5;
  const int tok0 = tb * 128;
  u32 top[2][16];
  f32x16 sc8[8];
#pragma unroll
  for (int mt = 0; mt < 8; ++mt)
#pragma unroll
    for (int i = 0; i < 16; ++i) sc8[mt][i] = 0.f;
  gemm_tile_n8<true>(p.w_qT + (size_t)(head * 256) * 1024, 1024, p.x1h + (size_t)tok0 * 1024, 1024, 1024, sc8, smem);
#pragma unroll
  for (int half = 0; half < 2; ++half) {
    f32x16 (&sc)[4] = *(f32x16 (*)[4])(&sc8[half * 4]);
    u32 kv[4][16];
#pragma unroll
    for (int mt = 0; mt < 4; ++mt) {
#pragma unroll
      for (int i = 0; i < 16; ++i) {
        const int key = mt * 32 + crow(i, h);
        kv[mt][i] = (f2key(sc[mt][i]) & ~127u) | (u32)(127 - key);
      }
      sort16_desc(kv[mt]);
    }
    merge16_desc(kv[0], kv[1]);
    merge16_desc(kv[2], kv[3]);
    merge16_desc(kv[0], kv[2]);
    u32 other[16];
#pragma unroll
    for (int i = 0; i < 16; ++i) other[i] = (u32)__shfl_xor((int)kv[0][i], 32);
    merge16_desc(kv[0], other);
#pragma unroll
    for (int i = 0; i < 16; ++i) top[half][i] = kv[0][i];
  }
  __syncthreads();
  int* sIdx = (int*)smem;
  float va[16], vb[16];
#pragma unroll
  for (int i = 0; i < 16; ++i) {
    va[i] = key2f(top[0][i] & ~127u); vb[i] = key2f(top[1][i] & ~127u);
    sIdx[tid * 33 + i] = 127 - (int)(top[0][i] & 127u);
    sIdx[tid * 33 + 16 + i] = 127 - (int)(top[1][i] & 127u);
  }
  u32 cd[4][16];
  {
    u32 c[64];
    int n = 0;
#pragma unroll
    for (int i = 0; i < 16; ++i)
#pragma unroll
      for (int j = 0; j < 16; ++j)
        if ((i + 1) * (j + 1) <= 16) { c[n] = (f2key(va[i] + vb[j]) & ~255u) | (u32)(255 - (i * 16 + j)); ++n; }
#pragma unroll
    for (int q = 50; q < 64; ++q) c[q] = 0u;
#pragma unroll
    for (int g = 0; g < 4; ++g)
#pragma unroll
      for (int i = 0; i < 16; ++i) cd[g][i] = c[g * 16 + i];
  }
#pragma unroll
  for (int g = 0; g < 4; ++g) sort16_desc(cd[g]);
  merge16_desc(cd[0], cd[1]);
  merge16_desc(cd[2], cd[3]);
  merge16_desc(cd[0], cd[2]);
  float sv[16], sum = 0.f;
  const float mx = key2f(cd[0][0] & ~255u);
#pragma unroll
  for (int i = 0; i < 16; ++i) { sv[i] = __expf(key2f(cd[0][i] & ~255u) - mx); sum += sv[i]; }
  const float inv = 1.f / sum;
  if (h == 0) {
    const size_t o = (size_t)(tok0 + w * 32 + r) * 128 + head * 16;
#pragma unroll
    for (int q = 0; q < 4; ++q) {
      int e[4]; f32x4 g;
#pragma unroll
      for (int c = 0; c < 4; ++c) {
        const int code = 255 - (int)(cd[0][q * 4 + c] & 255u);
        const int ea = sIdx[tid * 33 + (code >> 4)], eb = sIdx[tid * 33 + 16 + (code & 15)];
        e[c] = ea * 128 + eb;
        g[c] = sv[q * 4 + c] * inv;
      }
      *(u32x4*)(p.eid + o + q * 4) = (u32x4){(u32)e[0], (u32)e[1], (u32)e[2], (u32)e[3]};
      *(f32x4*)(p.gate + o + q * 4) = g;
    }
  }
  __syncthreads();
}

DI void phase4(const Params& p, char* smem) {
  for (int u = blockIdx.x; u < 1024; u += gridDim.x) {
#pragma unroll 2
    for (int i = threadIdx.x; i < 2048; i += 256) {
      const size_t i8 = (size_t)u * 2048 + i;
      cvt8_fp8(p.pu, (unsigned char*)p.u16t, i8, 512.f);
      cvt8_fp8(p.pv, (unsigned char*)p.v16t, i8, 64.f);
    }
    peer_route_unit(p, u >> 3, u & 7, smem);
  }
}

template <int CTRL, int ROWMASK>
DI float dpp_f(float v) {
  return __int_as_float(__builtin_amdgcn_update_dpp(0, __float_as_int(v), CTRL, ROWMASK, 0xF, false));
}
DI float dpp_sum_uniform(float v) {
  v += dpp_f<0xB1, 0xF>(v);
  v += dpp_f<0x4E, 0xF>(v);
  v += dpp_f<0x141, 0xF>(v);
  v += dpp_f<0x140, 0xF>(v);
  v += dpp_f<0x142, 0xA>(v);
  v += dpp_f<0x143, 0xC>(v);
  return __int_as_float(__builtin_amdgcn_readlane(__float_as_int(v), 63));
}
DI void sort128(u32& a, u32& b, int lane) {
#pragma unroll
  for (int k = 2; k <= 128; k <<= 1) {
#pragma unroll
    for (int j = k >> 1; j > 0; j >>= 1) {
      const bool up = ((2 * lane) & k) == 0;
      if (j == 1) {
        const u32 lo = umin(a, b), hi = umax(a, b);
        a = up ? lo : hi; b = up ? hi : lo;
      } else {
        const int m = j >> 1;
        const u32 oa = (u32)__shfl_xor((int)a, m), ob = (u32)__shfl_xor((int)b, m);
        const bool lower = (lane & m) == 0;
        a = (lower == up) ? umin(a, oa) : umax(a, oa);
        b = (lower == up) ? umin(b, ob) : umax(b, ob);
      }
    }
  }
}

constexpr int P5T = 4;
struct BatchU { u32x4 ru[8]; };
struct BatchV { u32x4 rv[8]; u32 pe[8]; };
struct P5Tabs { __amdgpu_buffer_rsrc_t ur, vr; };

DI u32 p5_entry(const u32 (&v0)[P5T], const u32 (&v1)[P5T], int i, int j) {
  const int st = j >> 2, t = j & 3;
  return (u32)__builtin_amdgcn_readlane((int)(st ? v1[t] : v0[t]), i);
}
DI void p5_issue_u(const P5Tabs& tb_, BatchU& bu, const u32 (&v0)[P5T], const u32 (&v1)[P5T], int i, int loff) {
#pragma unroll
  for (int j = 0; j < 8; ++j) {
    const u32 pe = p5_entry(v0, v1, i, j);
    bu.ru[j] = __builtin_bit_cast(u32x4, __builtin_amdgcn_raw_buffer_load_b128(tb_.ur, loff, (int)((pe >> 18) << 10), 0));
  }
}
DI void p5_issue_v(const P5Tabs& tb_, BatchV& bv, const u32 (&v0)[P5T], const u32 (&v1)[P5T], int i, int loff) {
#pragma unroll
  for (int j = 0; j < 8; ++j) {
    const u32 pe = p5_entry(v0, v1, i, j);
    bv.pe[j] = pe;
    bv.rv[j] = __builtin_bit_cast(u32x4, __builtin_amdgcn_raw_buffer_load_b128(tb_.vr, loff, (int)((pe >> 18) << 10), 0));
  }
}

template <int CTRL>
DI float dppx(float v) { return __int_as_float(__builtin_amdgcn_update_dpp(0, __float_as_int(v), CTRL, 0xF, 0xF, false)); }

DI float p5_dots(const BatchU& bu, const u32 (&pe)[8], const h2_t (&xh)[P5T][8], int lane) {
  float dv[8];
#pragma unroll
  for (int j = 0; j < 8; ++j) {
    const int t = j & 3;
    float d0 = 0.f, d1 = 0.f;
#pragma unroll
    for (int i = 0; i < 4; ++i) {
      const h2_t c0 = __builtin_amdgcn_cvt_scalef32_pk_f16_fp8((int)bu.ru[j][i], 1.0f, false);
      const h2_t c1 = __builtin_amdgcn_cvt_scalef32_pk_f16_fp8((int)bu.ru[j][i], 1.0f, true);
      d0 = __builtin_amdgcn_fdot2(c0, xh[t][2 * i], d0, false);
      d1 = __builtin_amdgcn_fdot2(c1, xh[t][2 * i + 1], d1, false);
    }
    dv[j] = d0 + d1;
  }
  const bool b0 = lane & 1, b1 = lane & 2, b2 = lane & 4;
  float r[4];
#pragma unroll
  for (int k = 0; k < 4; ++k) {
    const float z0 = b0 ? dv[2 * k + 1] : dv[2 * k], z1 = b0 ? dv[2 * k] : dv[2 * k + 1];
    r[k] = z0 + dppx<0xB1>(z1);
  }
  float q[2];
#pragma unroll
  for (int k = 0; k < 2; ++k) {
    const float z0 = b1 ? r[2 * k + 1] : r[2 * k], z1 = b1 ? r[2 * k] : r[2 * k + 1];
    q[k] = z0 + dppx<0x4E>(z1);
  }
  float tt;
  {
    const float z0 = b2 ? q[1] : q[0], z1 = b2 ? q[0] : q[1];
    tt = z0 + __int_as_float(__builtin_amdgcn_ds_swizzle(__float_as_int(z1), 0x101F));
  }
  tt += dppx<0x128>(tt);
  tt += __int_as_float(__builtin_amdgcn_ds_swizzle(__float_as_int(tt), 0x401F));
  tt += __shfl_xor(tt, 32);
  int gi = 0;
#pragma unroll
  for (int j = 0; j < 8; ++j) {
    const int gv = __builtin_amdgcn_readfirstlane((int)(pe[j] & 0x3FFFFu));
    asm volatile("v_writelane_b32 %0, %1, %2" : "+v"(gi) : "s"(gv), "i"(j));
  }
  return (float)gi * (1.f / (262143.f * 64.f)) * gelu_fast(tt * (1.f / 512.f));
}
DI void p5_accum(const BatchV& bv, float wv, f2_t (&acc)[P5T][8]) {
#pragma unroll
  for (int j = 0; j < 8; ++j) {
    const int t = j & 3;
    const float wgt = __int_as_float(__builtin_amdgcn_readlane(__float_as_int(wv), j));
    const f2_t w2 = {wgt, wgt};
#pragma unroll
    for (int i = 0; i < 4; ++i) {
      const f2_t lo = __builtin_amdgcn_cvt_pk_f32_fp8((int)bv.rv[j][i], false);
      const f2_t hi = __builtin_amdgcn_cvt_pk_f32_fp8((int)bv.rv[j][i], true);
      acc[t][2 * i] = lo * w2 + acc[t][2 * i];
      acc[t][2 * i + 1] = hi * w2 + acc[t][2 * i + 1];
    }
  }
}

DI void phase5(const Params& p) {
  const int lane = threadIdx.x & 63;
  const int gw = blockIdx.x * 4 + (threadIdx.x >> 6), nw = gridDim.x * 4;
  P5Tabs tabs;
  tabs.ur = __builtin_amdgcn_make_buffer_rsrc((void*)p.u16t, 0, 16 << 20, 0x00020000);
  tabs.vr = __builtin_amdgcn_make_buffer_rsrc((void*)p.v16t, 0, 16 << 20, 0x00020000);
  for (int tb = gw * P5T; tb < T_TOK; tb += nw * P5T) {
    h2_t xh[P5T][8];
    u32 v0[P5T], v1[P5T];
    f2_t acc[P5T][8];
    int lp = lane;
    asm volatile("" : "+v"(lp));
#pragma unroll
    for (int t = 0; t < P5T; ++t) {
      const u32x4* xr = (const u32x4*)(p.x1h + (size_t)(tb + t) * 1024 + lp * 16);
      const h8_t xa = __builtin_bit_cast(h8_t, xr[0]), xb = __builtin_bit_cast(h8_t, xr[1]);
#pragma unroll
      for (int i = 0; i < 4; ++i) { xh[t][i] = (h2_t){xa[2 * i], xa[2 * i + 1]}; xh[t][4 + i] = (h2_t){xb[2 * i], xb[2 * i + 1]}; }
      const size_t eo = (size_t)(tb + t) * 128 + 2 * lp;
      const u32 ea = (u32)p.eid[eo], eb = (u32)p.eid[eo + 1];
      const float ga = p.gate[eo], gb = p.gate[eo + 1];
      u32 pa = (ea << 18) | (u32)(ga * 262143.f + 0.5f);
      u32 pb = (eb << 18) | (u32)(gb * 262143.f + 0.5f);
      sort128(pa, pb, lp);
      v0[t] = pa; v1[t] = pb;
#pragma unroll
      for (int i = 0; i < 8; ++i) acc[t][i] = (f2_t){0.f, 0.f};
    }
    BatchU U;
    BatchV V;
    const int rev = ((tb / (nw * P5T)) & 1) ? 63 : 0;
    p5_issue_u(tabs, U, v0, v1, rev, lane * 16);
    p5_issue_v(tabs, V, v0, v1, rev, lane * 16);
#pragma unroll 1
    for (int i = 0; i < 64; ++i) {
      const float wv = p5_dots(U, V.pe, xh, lane);
      if (i + 1 < 64) p5_issue_u(tabs, U, v0, v1, rev ^ (i + 1), lane * 16);
      p5_accum(V, wv, acc);
      if (i + 1 < 64) p5_issue_v(tabs, V, v0, v1, rev ^ (i + 1), lane * 16);
    }
    int le = lane;
    asm volatile("" : "+v"(le));
#pragma unroll
    for (int t = 0; t < P5T; ++t) {
      asm volatile("" ::: "memory");
      float y[16];
      float sm = 0.f;
#pragma unroll
      for (int e = 0; e < 16; ++e) {
        y[e] = ALPHA * (float)xh[t][e >> 1][e & 1] + acc[t][e >> 1][e & 1];
        sm += y[e];
      }
      sm = wave_sum(sm);
      const float mu = sm * (1.f / 1024.f);
      float qv = 0.f;
#pragma unroll
      for (int i = 0; i < 16; ++i) { const float dd = y[i] - mu; qv += dd * dd; }
      qv = wave_sum(qv);
      const float rsd = rsqrtf(qv * (1.f / 1024.f) + LN_EPS);
#pragma unroll
      for (int q = 0; q < 4; ++q) {
        const int col = le * 16 + q * 4;
        const f32x4 g = *(const f32x4*)(p.ln2g + col), be = *(const f32x4*)(p.ln2b + col);
        f32x4 o;
#pragma unroll
        for (int c = 0; c < 4; ++c) o[c] = (y[q * 4 + c] - mu) * rsd * g[c] + be[c];
        *(f32x4*)(p.out + (size_t)(tb + t) * 1024 + col) = o;
      }
    }
  }
}

#define XB_TMO      128
#define XB_XCNT(j)  (256  + 64 * (j))
#define XB_XSUB(j)  (1280 + 64 * (j))
#define XB_XGEN(j)  (2304 + 64 * (j))
#define XB_TOP      3328
#define XB_TOPGEN   3392
#define XCD_BAR_WORDS 3456
#define XB_SPIN_CAP (1u << 18)
#define LAS __attribute__((address_space(3)))
DI unsigned xb_ld(unsigned* p) { return __hip_atomic_load(p, __ATOMIC_RELAXED, __HIP_MEMORY_SCOPE_AGENT); }
DI unsigned xb_add(unsigned* p, unsigned v) { return __hip_atomic_fetch_add(p, v, __ATOMIC_RELAXED, __HIP_MEMORY_SCOPE_AGENT); }
DI unsigned xb_xcc_id() { return (unsigned)__builtin_amdgcn_s_getreg((3 << 11) | 20) & 0xFu; }
#define XB_SPIN(cond, bar) do { unsigned _sp = 0; while (cond) { __builtin_amdgcn_s_sleep(1); \
    if ((++_sp & 255u) == 0u) { if (xb_ld(&(bar)[XB_TMO])) break; if (_sp > XB_SPIN_CAP) { atomicAdd(&(bar)[XB_TMO], 1u); break; } } } } while (0)
struct XcdBarrier { unsigned* bar; unsigned x; volatile LAS unsigned* st; };
DI XcdBarrier xcd_barrier_post(unsigned* bar, volatile LAS unsigned* st) {
  XcdBarrier b; b.bar = bar; b.x = xb_xcc_id(); b.st = st;
  if (threadIdx.x == 0) (void)xb_add(&bar[XB_XCNT(b.x)], 1u);
  return b;
}
DI void xcd_barrier_complete(unsigned* bar, unsigned x, unsigned& nloc, unsigned& nx) {
  const unsigned G = gridDim.x * gridDim.y * gridDim.z;
  unsigned sum, cnt, mine, sp = 0u;
  for (;;) {
    sum = 0u; cnt = 0u; mine = 0u;
#pragma unroll
    for (unsigned j = 0; j < 16; ++j) { const unsigned c = xb_ld(&bar[XB_XCNT(j)]); sum += c; cnt += (c > 0u) ? 1u : 0u; mine = (j == x) ? c : mine; }
    if (sum == G) break;
    __builtin_amdgcn_s_sleep(1);
    if ((++sp & 255u) == 0u) { if (xb_ld(&bar[XB_TMO])) break; if (sp > XB_SPIN_CAP) { atomicAdd(&bar[XB_TMO], 1u); break; } }
  }
  nloc = mine > 0u ? mine : 1u; nx = cnt > 0u ? cnt : 1u;
}
DI void xcd_barrier(const XcdBarrier& b) {
  asm volatile("s_waitcnt vmcnt(0)" ::: "memory");
  __syncthreads();
  if (threadIdx.x == 0) {
    unsigned* bar = b.bar;
    __builtin_amdgcn_s_waitcnt(0);
    unsigned nloc = b.st[0], nx = b.st[1];
    if (nloc == 0u) { xcd_barrier_complete(bar, b.x, nloc, nx); b.st[0] = nloc; b.st[1] = nx; }
    const unsigned old = xb_add(&bar[XB_XSUB(b.x)], 1u);
    const unsigned gen = old / nloc;
    if (old + 1u == (gen + 1u) * nloc) {
      __builtin_amdgcn_fence(__ATOMIC_RELEASE, "agent");
      asm volatile("s_waitcnt vmcnt(0)" ::: "memory");
      const unsigned og = xb_add(&bar[XB_TOP], 1u);
      const unsigned tg = og / nx;
      if (og + 1u == (tg + 1u) * nx) xb_add(&bar[XB_TOPGEN], 1u);
      else XB_SPIN(xb_ld(&bar[XB_TOPGEN]) == tg, bar);
      __builtin_amdgcn_fence(__ATOMIC_ACQUIRE, "agent");
      xb_add(&bar[XB_XGEN(b.x)], 1u);
      asm volatile("s_waitcnt vmcnt(0)" ::: "memory");
    } else {
      XB_SPIN(xb_ld(&bar[XB_XGEN(b.x)]) == gen, bar);
      __builtin_amdgcn_fence(__ATOMIC_ACQUIRE, "agent");
      asm volatile("s_waitcnt vmcnt(0)" ::: "memory");
    }
  }
  __syncthreads();
}

__global__ void __launch_bounds__(256, 2) mega(Params p, int lo, int hi) {
  __shared__ __attribute__((aligned(16))) char smem[65536];
  __shared__ uint4 xb_words;
  cg::grid_group grid = cg::this_grid();
  if (lo > 1000) grid.sync();
  if (threadIdx.x == 0) xb_words = make_uint4(0u, 0u, 0u, 0u);
  __syncthreads();
  XcdBarrier xb = xcd_barrier_post(p.bar, (volatile LAS unsigned*)&xb_words);
#ifndef ONLY_PHASE
#define ONLY_PHASE -1
#endif
#define RUNPH(n) (lo <= n && n < hi && (ONLY_PHASE < 0 || ONLY_PHASE == n))
#define SYNCPH(n) if (lo <= n && n + 1 < hi) xcd_barrier(xb);
  if (RUNPH(0)) phase0(p, smem);
  SYNCPH(0)
  if (RUNPH(1)) phase1(p, smem);
  SYNCPH(1)
  if (RUNPH(2)) phase2(p, smem);
  SYNCPH(2)
  if (RUNPH(3)) phase3(p, smem);
  SYNCPH(3)
  if (RUNPH(3)) phase3b(p);
  SYNCPH(3)
  if (RUNPH(4)) phase4(p, smem);
  SYNCPH(4)
  if (RUNPH(5)) phase5(p);
}

extern "C" void kernel_launch(void* const* d_in, const int* in_sizes, int n_in, void* d_out, int out_size, void* d_ws,
                              size_t ws_size, hipStream_t stream) {
  Params p{};
  const float** f = (const float**)&p;
  for (int i = 0; i < 21; ++i) f[i] = (const float*)d_in[i];
  p.out = (float*)d_out;
  char* ws = (char*)d_ws;
  size_t off = 0;
  auto take = [&](size_t bytes) { char* r = ws + off; off += (bytes + 255) & ~(size_t)255; return r; };
  const size_t MB = 1u << 20;
  char* X = take(64 * MB);
  p.xb = (u16*)X; p.mixcat = (u16*)(X + 32 * MB);
  p.x1f = (float*)X;
  p.u16t = (u16*)take(16 * MB);
  p.v16t = (u16*)take(16 * MB);
  char* R = take(80 * MB);
  p.zu = (u16*)R; p.zvT = (u16*)(R + 16 * MB); p.qb = (u16*)(R + 32 * MB); p.kb = (u16*)(R + 48 * MB); p.vT = (u16*)(R + 64 * MB);
  p.y1 = (float*)R;
  p.w_inT = (u16*)take(5 * MB);
  p.w_oT = (u16*)take(2 * MB);
  p.w_qT = (u16*)take(4 * MB);
  p.keysh = (u16*)take(512 * 1024);
  p.wsb = (u16*)take(128 * 1024);
  p.bar = (unsigned*)take((XCD_BAR_WORDS + 64 + 1024) * 4);
  p.stats = p.bar + XCD_BAR_WORDS;
  p.lnst = (float*)take((size_t)T_TOK * 2 * 4);
  const size_t tail0 = off;
  p.x1h = (u16*)take(32 * MB);
  p.eid = (int*)take(8 * MB);
  p.gate = (float*)take(8 * MB);
  p.part = (char*)ws + tail0;
  if (tail0 + (size_t)2048 * ATT_SLOT > off) off = tail0 + (size_t)2048 * ATT_SLOT;
  if (off > ws_size) { fprintf(stderr, "workspace too small: need %zu have %zu\n", off, ws_size); return; }
  static int grid_blocks = 0;
  if (!grid_blocks) {
    int dev = 0, cus = 0, per_cu = 0;
    hipGetDevice(&dev);
    hipDeviceGetAttribute(&cus, hipDeviceAttributeMultiprocessorCount, dev);
    hipOccupancyMaxActiveBlocksPerMultiprocessor(&per_cu, mega, 256, 0);
    if (per_cu > 2) per_cu = 2;
    grid_blocks = cus * per_cu;
  }
  hipMemsetAsync(p.bar, 0, (XCD_BAR_WORDS + 64 + 1024) * 4, stream);
#ifdef MULTI_LAUNCH
  for (int ph = 0; ph < 6; ++ph) hipLaunchKernelGGL(mega, dim3(grid_blocks), dim3(256), 0, stream, p, ph, ph + 1);
#else
  int lo = 0, hi = 6;
  void* args[] = {&p, &lo, &hi};
  hipError_t e = hipLaunchCooperativeKernel((void*)mega, dim3(grid_blocks), dim3(256), args, 0, stream);
  if (e != hipSuccess) fprintf(stderr, "cooperative launch failed: %s (grid %d)\n", hipGetErrorString(e), grid_blocks);
#endif
}
```

```cpp
#include <hip/hip_runtime.h>
#include <hip/hip_cooperative_groups.h>
#include <cstdio>
namespace cg = cooperative_groups;

#define DI __device__ __forceinline__
typedef unsigned short u16;
typedef unsigned int u32;
typedef __attribute__((ext_vector_type(2))) __bf16 bf2_t;
typedef __attribute__((ext_vector_type(2))) float f2_t;
typedef __attribute__((ext_vector_type(2))) _Float16 h2_t;
typedef __attribute__((ext_vector_type(8))) _Float16 h8_t;
typedef __attribute__((ext_vector_type(8))) short s8_t;
typedef __attribute__((ext_vector_type(16))) float f32x16;
typedef __attribute__((ext_vector_type(4))) u32 u32x4;
typedef __attribute__((ext_vector_type(2))) u32 u32x2;
typedef __attribute__((ext_vector_type(4))) float f32x4;

constexpr int T_TOK = 16384;
constexpr int SEQ = 8192;
constexpr float ALPHA = 1.189207115002721f;
constexpr float LN_EPS = 1e-5f;
constexpr float LOG2E = 1.4426950408889634f;
#define LOG2E_C 1.4426950408889634f

struct Params {
  const float *x, *w_in, *gm_g, *gm_b, *gm_ws, *gm_bs, *lq1, *lk1, *lq2, *lk2, *da_g, *w_o, *ln1g, *ln1b,
      *w_q, *keys_a, *keys_b, *pu, *pv, *ln2g, *ln2b;
  float* out;
  u16 *xb, *mixcat, *u16t, *v16t, *zu, *zvT, *qb, *kb, *vT, *x1h, *w_inT, *w_oT, *w_qT, *keysh, *wsb;
  float* x1f;
  int* eid;
  float* gate;
  float* y1;
  unsigned* bar;
  float* lnst;
  char* part;
  unsigned* stats;
};

DI u32 pack_bf2(float a, float b) { f2_t v = {a, b}; bf2_t r = __builtin_convertvector(v, bf2_t); return __builtin_bit_cast(u32, r); }
DI u32 pack_h2(float a, float b) { f2_t v = {a, b}; h2_t r = __builtin_convertvector(v, h2_t); return __builtin_bit_cast(u32, r); }
DI float bf_lo(u32 u) { return __uint_as_float(u << 16); }
DI float bf_hi(u32 u) { return __uint_as_float(u & 0xffff0000u); }
DI float bf2f(u16 u) { return __uint_as_float(((u32)u) << 16); }
DI float gelu_f(float x) { return 0.5f * x * (1.f + erff(x * 0.70710678118654752f)); }
DI float gelu_fast(float x) {
  const float z = fabsf(x) * 0.70710678118654752f;
  const float t = __builtin_amdgcn_rcpf(1.f + 0.3275911f * z);
  const float poly = t * (0.254829592f + t * (-0.284496736f + t * (1.421413741f + t * (-1.453152027f + t * 1.061405429f))));
  const float e = poly * __builtin_amdgcn_exp2f(-z * z * LOG2E_C);
  const float erfabs = 1.f - e;
  const float erfv = x < 0.f ? -erfabs : erfabs;
  return 0.5f * x * (1.f + erfv);
}
DI float wave_sum(float v) {
#pragma unroll
  for (int o = 32; o > 0; o >>= 1) v += __shfl_xor(v, o);
  return v;
}
DI int ltid() { int t = threadIdx.x; asm volatile("" : "+v"(t)); return t; }
DI int crow(int i, int h) { return (i & 3) + 8 * (i >> 2) + 4 * h; }

template <bool F16>
DI f32x16 mfma32(u32x4 a, u32x4 b, f32x16 c) {
  if constexpr (F16)
    return __builtin_amdgcn_mfma_f32_32x32x16_f16(__builtin_bit_cast(h8_t, a), __builtin_bit_cast(h8_t, b), c, 0, 0, 0);
  else
    return __builtin_amdgcn_mfma_f32_32x32x16_bf16(__builtin_bit_cast(s8_t, a), __builtin_bit_cast(s8_t, b), c, 0, 0, 0);
}

template <int TM, int TN, bool F16>
DI void gemm_tile(const u16* __restrict__ A, int lda, const u16* __restrict__ B, int ldb, int K,
                  f32x16 (&acc)[TM][TN], char* smem) {
  static_assert(TM == 2 && TN == 2, "128x128 tile only");
  const int tid = ltid(), lane = tid & 63, w = tid >> 6, wm = w >> 1, wn = w & 1, r = lane & 31, h = lane >> 5;
  typedef __attribute__((address_space(1))) void gvoid;
  typedef __attribute__((address_space(3))) void lvoid;
  const u16* asrc[4];
  const u16* bsrc[4];
#pragma unroll
  for (int j = 0; j < 4; ++j) {
    const int row = (w * 4 + j) * 8 + (lane >> 3);
    const int c = (lane & 7) ^ ((row >> 1) & 7);
    asrc[j] = A + (size_t)row * lda + c * 8;
    bsrc[j] = B + (size_t)row * ldb + c * 8;
  }
  __syncthreads();
#pragma unroll
  for (int j = 0; j < 4; ++j) {
    __builtin_amdgcn_global_load_lds((const gvoid*)asrc[j], (lvoid*)(smem + (w * 4 + j) * 1024), 16, 0, 0);
    __builtin_amdgcn_global_load_lds((const gvoid*)bsrc[j], (lvoid*)(smem + 16384 + (w * 4 + j) * 1024), 16, 0, 0);
  }
  asm volatile("s_waitcnt vmcnt(0)" ::: "memory");
  __syncthreads();
  const int swz = (r >> 1) & 7;
  for (int k0 = 0; k0 < K; k0 += 64) {
    const char* buf = smem + ((k0 >> 6) & 1) * 32768;
    if (k0 + 64 < K) {
      char* nb = smem + (((k0 >> 6) + 1) & 1) * 32768;
#pragma unroll
      for (int j = 0; j < 4; ++j) {
        __builtin_amdgcn_global_load_lds((const gvoid*)(asrc[j] + k0 + 64), (lvoid*)(nb + (w * 4 + j) * 1024), 16, 0, 0);
        __builtin_amdgcn_global_load_lds((const gvoid*)(bsrc[j] + k0 + 64), (lvoid*)(nb + 16384 + (w * 4 + j) * 1024), 16, 0, 0);
      }
    }
#pragma unroll
    for (int ks = 0; ks < 4; ++ks) {
      u32x4 af[2], bfr[2];
      const int co = ((ks * 2 + h) ^ swz) << 4;
#pragma unroll
      for (int mt = 0; mt < 2; ++mt) af[mt] = *(const u32x4*)(buf + (wm * 64 + mt * 32 + r) * 128 + co);
#pragma unroll
      for (int nt = 0; nt < 2; ++nt) bfr[nt] = *(const u32x4*)(buf + 16384 + (wn * 64 + nt * 32 + r) * 128 + co);
#pragma unroll
      for (int mt = 0; mt < 2; ++mt)
#pragma unroll
        for (int nt = 0; nt < 2; ++nt) acc[mt][nt] = mfma32<F16>(af[mt], bfr[nt], acc[mt][nt]);
    }
    asm volatile("s_waitcnt vmcnt(0)" ::: "memory");
    __syncthreads();
  }
}

template <bool F16>
DI void gemm_tile_n4(const u16* __restrict__ A, int lda, const u16* __restrict__ B, int ldb, int K, f32x16 (&acc)[4], char* smem) {
  const int tid = ltid(), lane = tid & 63, w = tid >> 6, r = lane & 31, h = lane >> 5;
  typedef __attribute__((address_space(1))) void gvoid;
  typedef __attribute__((address_space(3))) void lvoid;
  const u16* asrc[4];
  const u16* bsrc[4];
#pragma unroll
  for (int j = 0; j < 4; ++j) {
    const int row = (w * 4 + j) * 8 + (lane >> 3);
    const int c = (lane & 7) ^ ((row >> 1) & 7);
    asrc[j] = A + (size_t)row * lda + c * 8;
    bsrc[j] = B + (size_t)row * ldb + c * 8;
  }
  __syncthreads();
#pragma unroll
  for (int j = 0; j < 4; ++j) {
    __builtin_amdgcn_global_load_lds((const gvoid*)asrc[j], (lvoid*)(smem + (w * 4 + j) * 1024), 16, 0, 0);
    __builtin_amdgcn_global_load_lds((const gvoid*)bsrc[j], (lvoid*)(smem + 16384 + (w * 4 + j) * 1024), 16, 0, 0);
  }
  asm volatile("s_waitcnt vmcnt(0)" ::: "memory");
  __syncthreads();
  const int swz = (r >> 1) & 7;
  for (int k0 = 0; k0 < K; k0 += 64) {
    const char* buf = smem + ((k0 >> 6) & 1) * 32768;
    if (k0 + 64 < K) {
      char* nb = smem + (((k0 >> 6) + 1) & 1) * 32768;
#pragma unroll
      for (int j = 0; j < 4; ++j) {
        __builtin_amdgcn_global_load_lds((const gvoid*)(asrc[j] + k0 + 64), (lvoid*)(nb + (w * 4 + j) * 1024), 16, 0, 0);
        __builtin_amdgcn_global_load_lds((const gvoid*)(bsrc[j] + k0 + 64), (lvoid*)(nb + 16384 + (w * 4 + j) * 1024), 16, 0, 0);
      }
    }
#pragma unroll
    for (int ks = 0; ks < 4; ++ks) {
      const int co = ((ks * 2 + h) ^ swz) << 4;
      const u32x4 bfr = *(const u32x4*)(buf + 16384 + (w * 32 + r) * 128 + co);
      u32x4 af[4];
#pragma unroll
      for (int mt = 0; mt < 4; ++mt) af[mt] = *(const u32x4*)(buf + (mt * 32 + r) * 128 + co);
#pragma unroll
      for (int mt = 0; mt < 4; ++mt) acc[mt] = mfma32<F16>(af[mt], bfr, acc[mt]);
    }
    asm volatile("s_waitcnt vmcnt(0)" ::: "memory");
    __syncthreads();
  }
}

template <bool F16>
DI void gemm_tile_n8(const u16* __restrict__ A, int lda, const u16* __restrict__ B, int ldb, int K, f32x16 (&acc)[8], char* smem) {
  const int tid = ltid(), lane = tid & 63, w = tid >> 6, r = lane & 31, h = lane >> 5;
  typedef __attribute__((address_space(1))) void gvoid;
  typedef __attribute__((address_space(3))) void lvoid;
  const u16* asrc[4];
  const u16* bsrc[2];
#pragma unroll
  for (int j = 0; j < 4; ++j) {
    const int row = (w * 4 + j) * 16 + (lane >> 2);
    asrc[j] = A + (size_t)row * lda + (((lane & 3) ^ ((row >> 2) & 3)) << 3);
  }
#pragma unroll
  for (int j = 0; j < 2; ++j) {
    const int row = (w * 2 + j) * 16 + (lane >> 2);
    bsrc[j] = B + (size_t)row * ldb + (((lane & 3) ^ ((row >> 2) & 3)) << 3);
  }
  __syncthreads();
#pragma unroll
  for (int j = 0; j < 4; ++j) __builtin_amdgcn_global_load_lds((const gvoid*)asrc[j], (lvoid*)(smem + (w * 4 + j) * 1024), 16, 0, 0);
#pragma unroll
  for (int j = 0; j < 2; ++j) __builtin_amdgcn_global_load_lds((const gvoid*)bsrc[j], (lvoid*)(smem + 16384 + (w * 2 + j) * 1024), 16, 0, 0);
  asm volatile("s_waitcnt vmcnt(0)" ::: "memory");
  __syncthreads();
  const int swz = (r >> 2) & 3;
  for (int k0 = 0; k0 < K; k0 += 32) {
    const char* buf = smem + ((k0 >> 5) & 1) * 24576;
    if (k0 + 32 < K) {
      char* nb = smem + (((k0 >> 5) + 1) & 1) * 24576;
#pragma unroll
      for (int j = 0; j < 4; ++j) __builtin_amdgcn_global_load_lds((const gvoid*)(asrc[j] + k0 + 32), (lvoid*)(nb + (w * 4 + j) * 1024), 16, 0, 0);
#pragma unroll
      for (int j = 0; j < 2; ++j) __builtin_amdgcn_global_load_lds((const gvoid*)(bsrc[j] + k0 + 32), (lvoid*)(nb + 16384 + (w * 2 + j) * 1024), 16, 0, 0);
    }
#pragma unroll
    for (int ks = 0; ks < 2; ++ks) {
      const int co = ((ks * 2 + h) ^ swz) << 4;
      const u32x4 bfr = *(const u32x4*)(buf + 16384 + (w * 32 + r) * 64 + co);
#pragma unroll
      for (int mt = 0; mt < 8; ++mt) {
        const u32x4 af = *(const u32x4*)(buf + (mt * 32 + r) * 64 + co);
        acc[mt] = mfma32<F16>(af, bfr, acc[mt]);
      }
    }
    asm volatile("s_waitcnt vmcnt(0)" ::: "memory");
    __syncthreads();
  }
}

DI void wk_tile(const Params& p, int hh16, int nt, char* smem) {
  const int tid = threadIdx.x, lane = tid & 63, w = tid >> 6, wm = w >> 1, wn = w & 1, r = lane & 31, h = lane >> 5;
  u16* sA = (u16*)smem;
  u16* sB = sA + 128 * 72;
  const float* ksrc = ((hh16 & 1) ? p.keys_b : p.keys_a) + (size_t)(hh16 >> 1) * 16384;
  const float* wsrc = p.w_q + (size_t)(nt * 128) * 2048 + hh16 * 128;
  f32x16 acc[2][2];
#pragma unroll
  for (int a = 0; a < 2; ++a)
#pragma unroll
    for (int b = 0; b < 2; ++b)
#pragma unroll
      for (int i = 0; i < 16; ++i) acc[a][b][i] = 0.f;
  for (int dh = 0; dh < 2; ++dh) {
    __syncthreads();
#pragma unroll
    for (int i = 0; i < 8; ++i) {
      const int idx = tid + 256 * i, row = idx >> 4, c4 = (idx & 15) * 4;
      const f32x4 kv = *(const f32x4*)(ksrc + row * 128 + dh * 64 + c4);
      const f32x4 wv = *(const f32x4*)(wsrc + (size_t)row * 2048 + dh * 64 + c4);
      *(u32x2*)(sA + row * 72 + c4) = (u32x2){pack_h2(kv[0], kv[1]), pack_h2(kv[2], kv[3])};
      *(u32x2*)(sB + row * 72 + c4) = (u32x2){pack_h2(wv[0], wv[1]), pack_h2(wv[2], wv[3])};
    }
    __syncthreads();
#pragma unroll
    for (int ks = 0; ks < 4; ++ks) {
      u32x4 af[2], bfr[2];
#pragma unroll
      for (int mt = 0; mt < 2; ++mt) af[mt] = *(const u32x4*)(sA + (wm * 64 + mt * 32 + r) * 72 + ks * 16 + 8 * h);
#pragma unroll
      for (int nt2 = 0; nt2 < 2; ++nt2) bfr[nt2] = *(const u32x4*)(sB + (wn * 64 + nt2 * 32 + r) * 72 + ks * 16 + 8 * h);
#pragma unroll
      for (int mt = 0; mt < 2; ++mt)
#pragma unroll
        for (int nt2 = 0; nt2 < 2; ++nt2) acc[mt][nt2] = mfma32<true>(af[mt], bfr[nt2], acc[mt][nt2]);
    }
  }
  u16* dst = p.w_qT + (size_t)hh16 * 128 * 1024 + nt * 128;
#pragma unroll
  for (int a = 0; a < 2; ++a)
#pragma unroll
    for (int b = 0; b < 2; ++b)
#pragma unroll
      for (int i = 0; i < 16; ++i)
        dst[(size_t)(wm * 64 + a * 32 + crow(i, h)) * 1024 + wn * 64 + b * 32 + r] = (u16)(pack_h2(acc[a][b][i], 0.f) & 0xffff);
}

template <bool F16>
DI void cvt8(const float* __restrict__ src, u16* __restrict__ dst, size_t i8) {
  const f32x4 a = *(const f32x4*)(src + i8 * 8), b = *(const f32x4*)(src + i8 * 8 + 4);
  u32x4 o;
  if constexpr (F16) { o[0] = pack_h2(a[0], a[1]); o[1] = pack_h2(a[2], a[3]); o[2] = pack_h2(b[0], b[1]); o[3] = pack_h2(b[2], b[3]); }
  else { o[0] = pack_bf2(a[0], a[1]); o[1] = pack_bf2(a[2], a[3]); o[2] = pack_bf2(b[0], b[1]); o[3] = pack_bf2(b[2], b[3]); }
  *(u32x4*)(dst + i8 * 8) = o;
}

DI void cvt8_fp8(const float* __restrict__ src, unsigned char* __restrict__ dst, size_t i8, float sc) {
  const f32x4 a = *(const f32x4*)(src + i8 * 8), b = *(const f32x4*)(src + i8 * 8 + 4);
  int w0 = 0, w1 = 0;
  w0 = __builtin_amdgcn_cvt_pk_fp8_f32(a[0] * sc, a[1] * sc, w0, false);
  w0 = __builtin_amdgcn_cvt_pk_fp8_f32(a[2] * sc, a[3] * sc, w0, true);
  w1 = __builtin_amdgcn_cvt_pk_fp8_f32(b[0] * sc, b[1] * sc, w1, false);
  w1 = __builtin_amdgcn_cvt_pk_fp8_f32(b[2] * sc, b[3] * sc, w1, true);
  *(u32x2*)(dst + i8 * 8) = (u32x2){(u32)w0, (u32)w1};
}

template <bool F16>
DI void transpose_tile(const float* __restrict__ W, int N, u16* __restrict__ WT, int kt, int nt, char* smem) {
  float* sT = (float*)smem;
  const int tid = threadIdx.x;
  __syncthreads();
#pragma unroll
  for (int i = 0; i < 4; ++i) {
    const int row = (tid >> 4) + 16 * i, c4 = (tid & 15) * 4;
    const f32x4 v = *(const f32x4*)(W + (size_t)(kt * 64 + row) * N + nt * 64 + c4);
    sT[row * 65 + c4 + 0] = v[0]; sT[row * 65 + c4 + 1] = v[1]; sT[row * 65 + c4 + 2] = v[2]; sT[row * 65 + c4 + 3] = v[3];
  }
  __syncthreads();
  const int n = tid >> 2, ks = (tid & 3) * 16;
  u32 o[8];
#pragma unroll
  for (int j = 0; j < 8; ++j) {
    const float a = sT[(ks + 2 * j) * 65 + n], b = sT[(ks + 2 * j + 1) * 65 + n];
    o[j] = F16 ? pack_h2(a, b) : pack_bf2(a, b);
  }
  u16* d = WT + (size_t)(nt * 64 + n) * 1024 + kt * 64 + ks;
  *(u32x4*)d = (u32x4){o[0], o[1], o[2], o[3]};
  *(u32x4*)(d + 8) = (u32x4){o[4], o[5], o[6], o[7]};
}

DI void phase0(const Params& p, char* smem) {
  const size_t gt = (size_t)blockIdx.x * 256 + threadIdx.x, gs = (size_t)gridDim.x * 256;
  for (size_t i = gt; i < (size_t)T_TOK * 1024 / 8; i += gs) cvt8<false>(p.x, p.xb, i);
  for (size_t i = gt; i < (size_t)T_TOK * 2; i += gs) p.lnst[i] = 0.f;
  for (size_t i = gt; i < 131072 / 8; i += gs) { cvt8<true>(p.keys_a, p.keysh, i); cvt8<true>(p.keys_b, p.keysh + 131072, i); }
  for (size_t i = gt; i < 65536; i += gs) {
    const int t = (i >> 7) & 127, s = i & 127;
    p.wsb[i] = (u16)(pack_bf2(s <= t ? p.gm_ws[i] : 0.f, 0.f) & 0xffff);
  }
  for (int t = blockIdx.x; t < 640 + 256 + 128; t += gridDim.x) {
    if (t < 640) transpose_tile<false>(p.w_in, 2560, p.w_inT, t / 40, t % 40, smem);
    else if (t < 896) transpose_tile<false>(p.w_o, 1024, p.w_oT, (t - 640) / 16, (t - 640) % 16, smem);
    else wk_tile(p, (t - 896) >> 3, (t - 896) & 7, smem);
  }
}

DI void phase1(const Params& p, char* smem) {
  const int lane = threadIdx.x & 63, w = threadIdx.x >> 6, wm = w >> 1, wn = w & 1, r = lane & 31, h = lane >> 5;
  for (int t = blockIdx.x; t < 128 * 20; t += gridDim.x) {
    const int mt_ = t / 20, nt_ = t % 20;
    const int m0 = mt_ * 128, n0 = nt_ * 128;
    const bool swapped = (n0 >= 512 && n0 < 1024) || (n0 >= 2048);
    f32x16 acc[2][2];
#pragma unroll
    for (int a = 0; a < 2; ++a)
#pragma unroll
      for (int b = 0; b < 2; ++b)
#pragma unroll
        for (int i = 0; i < 16; ++i) acc[a][b][i] = 0.f;
    if (!swapped) {
      gemm_tile<2, 2, false>(p.xb + (size_t)m0 * 1024, 1024, p.w_inT + (size_t)n0 * 1024, 1024, 1024, acc, smem);
      u16* dst; int cb; int mode;
      if (n0 < 512) { dst = p.zu; cb = n0; mode = 0; }
      else if (n0 < 1536) { dst = p.qb; cb = n0 - 1024; mode = 1; }
      else { dst = p.kb; cb = n0 - 1536; mode = 2; }
      float nmax = 0.f;
      u16* sC = (u16*)smem;
      __syncthreads();
#pragma unroll
      for (int a = 0; a < 2; ++a)
#pragma unroll
        for (int i = 0; i < 16; ++i) {
          float sq = 0.f;
#pragma unroll
          for (int b = 0; b < 2; ++b) {
            float v = acc[a][b][i];
            if (mode == 0) v = gelu_fast(v);
            else if (mode == 1) v *= 0.125f * LOG2E;
            const u32 pk = pack_bf2(v, 0.f);
            const float vr = bf_lo(pk);
            sq += vr * vr;
            sC[(wm * 64 + a * 32 + crow(i, h)) * 136 + wn * 64 + b * 32 + r] = (u16)(pk & 0xffff);
          }
          if (mode != 0) {
#pragma unroll
            for (int o = 1; o < 32; o <<= 1) sq += __shfl_xor(sq, o);
            nmax = fmaxf(nmax, sq);
          }
        }
      if (mode != 0) {
        nmax = fmaxf(nmax, __shfl_xor(nmax, 32));
        if (lane == 0) atomicMax(p.stats + (mode == 2 ? 16 : 0) + ((m0 >> 13) * 4 + (cb >> 7)) * 2 + wn, __float_as_uint(nmax));
      }
      __syncthreads();
#pragma unroll
      for (int i = 0; i < 8; ++i) {
        const int idx = threadIdx.x + 256 * i, t = idx >> 4, c = idx & 15;
        *(u32x4*)(dst + (size_t)(m0 + t) * 512 + cb + c * 8) = *(const u32x4*)(sC + t * 136 + c * 8);
      }
    } else {
      gemm_tile<2, 2, false>(p.w_inT + (size_t)n0 * 1024, 1024, p.xb + (size_t)m0 * 1024, 1024, 1024, acc, smem);
      const bool isz = n0 < 1024;
      u16* dst = isz ? p.zvT : p.vT;
      const int cb = isz ? n0 - 512 : n0 - 2048;
      const int bb = m0 >> 13, s0 = m0 & 8191;
      u16* sC = (u16*)smem;
      __syncthreads();
#pragma unroll
      for (int a = 0; a < 2; ++a)
#pragma unroll
        for (int b = 0; b < 2; ++b)
#pragma unroll
          for (int i = 0; i < 16; ++i) {
            float v = acc[a][b][i];
            if (isz) v = gelu_fast(v);
            const u32 pk = pack_bf2(v, 0.f);
            acc[a][b][i] = bf_lo(pk);
            sC[(wm * 64 + a * 32 + crow(i, h)) * 136 + wn * 64 + b * 32 + r] = (u16)(pk & 0xffff);
          }
      if (isz) {
#pragma unroll
        for (int b = 0; b < 2; ++b) {
          float sm = 0.f, sq = 0.f;
#pragma unroll
          for (int a = 0; a < 2; ++a)
#pragma unroll
            for (int i = 0; i < 16; ++i) { const float v = acc[a][b][i]; sm += v; sq += v * v; }
          sm += __shfl_xor(sm, 32); sq += __shfl_xor(sq, 32);
          if (h == 0) {
            float* st = p.lnst + (size_t)(m0 + wn * 64 + b * 32 + r) * 2;
            atomicAdd(st, sm); atomicAdd(st + 1, sq);
          }
        }
      }
      __syncthreads();
#pragma unroll
      for (int i = 0; i < 8; ++i) {
        const int idx = threadIdx.x + 256 * i, t = idx >> 4, c = idx & 15;
        *(u32x4*)(dst + ((size_t)bb * 512 + cb + t) * SEQ + s0 + c * 8) = *(const u32x4*)(sC + t * 136 + c * 8);
      }
    }
  }
}

DI void gmlp_unit(const Params& p, int chunk, int hh, char* smem) {
  const int tid = ltid(), lane = tid & 63, w = tid >> 6, wm = w >> 1, wn = w & 1, r = lane & 31, h = lane >> 5;
  const int tok0 = chunk * 128, bb = tok0 >> 13, s0 = tok0 & 8191;
  float* sMu = (float*)smem;
  float* sRs = sMu + 128;
  float* sPart = sRs + 128;
  u16* sA = (u16*)(smem + 17408);
  u16* sB = sA + 128 * 72;
  __syncthreads();
  if (tid < 128) {
    const float sa = p.lnst[(size_t)(tok0 + tid) * 2], sb = p.lnst[(size_t)(tok0 + tid) * 2 + 1];
    const float mu = sa * (1.f / 512.f);
    const float var = fmaxf(sb * (1.f / 512.f) - mu * mu, 0.f);
    sMu[tid] = mu; sRs[tid] = rsqrtf(var + LN_EPS);
  }
  f32x16 acc[2][2];
#pragma unroll
  for (int a = 0; a < 2; ++a)
#pragma unroll
    for (int b = 0; b < 2; ++b)
#pragma unroll
      for (int i = 0; i < 16; ++i) acc[a][b][i] = 0.f;
  for (int kh = 0; kh < 2; ++kh) {
    __syncthreads();
#pragma unroll
    for (int i = 0; i < 4; ++i) {
      const int idx = tid + 256 * i, row = idx >> 3, c = idx & 7;
      *(u32x4*)(sA + row * 72 + c * 8) = *(const u32x4*)(p.wsb + (size_t)hh * 16384 + row * 128 + kh * 64 + c * 8);
      const int ch = hh * 128 + row;
      const u32x4 v = *(const u32x4*)(p.zvT + ((size_t)bb * 512 + ch) * SEQ + s0 + kh * 64 + c * 8);
      const float g = p.gm_g[ch], be = p.gm_b[ch];
      u32x4 o;
#pragma unroll
      for (int j = 0; j < 4; ++j) {
        const int s = kh * 64 + c * 8 + 2 * j;
        const float a = (bf_lo(v[j]) - sMu[s]) * sRs[s] * g + be;
        const float b = (bf_hi(v[j]) - sMu[s + 1]) * sRs[s + 1] * g + be;
        o[j] = pack_bf2(a, b);
      }
      *(u32x4*)(sB + row * 72 + c * 8) = o;
    }
    __syncthreads();
#pragma unroll
    for (int ks = 0; ks < 4; ++ks) {
      u32x4 af[2], bfr[2];
#pragma unroll
      for (int mt = 0; mt < 2; ++mt) af[mt] = *(const u32x4*)(sA + (wm * 64 + mt * 32 + r) * 72 + ks * 16 + 8 * h);
#pragma unroll
      for (int nt = 0; nt < 2; ++nt) bfr[nt] = *(const u32x4*)(sB + (wn * 64 + nt * 32 + r) * 72 + ks * 16 + 8 * h);
#pragma unroll
      for (int mt = 0; mt < 2; ++mt)
#pragma unroll
        for (int nt = 0; nt < 2; ++nt) acc[mt][nt] = mfma32<false>(af[mt], bfr[nt], acc[mt][nt]);
    }
  }
  __syncthreads();
  {
    u16* sC = (u16*)smem;
#pragma unroll
    for (int a = 0; a < 2; ++a)
#pragma unroll
      for (int i = 0; i < 16; ++i) {
        const int t = wm * 64 + a * 32 + crow(i, h);
        const float bs = p.gm_bs[hh * 128 + t];
#pragma unroll
        for (int b = 0; b < 2; ++b) sC[t * 136 + wn * 64 + b * 32 + r] = (u16)(pack_bf2(acc[a][b][i] + bs, 0.f) & 0xffff);
      }
    __syncthreads();
#pragma unroll
    for (int i = 0; i < 8; ++i) {
      const int idx = tid + 256 * i, t = idx >> 4, c = idx & 15;
      const u32x4 mv = *(const u32x4*)(sC + t * 136 + c * 8);
      const u32x4 uv = *(const u32x4*)(p.zu + (size_t)(tok0 + t) * 512 + hh * 128 + c * 8);
      u32x4 o;
#pragma unroll
      for (int j = 0; j < 4; ++j) o[j] = pack_bf2(bf_lo(mv[j]) * bf_lo(uv[j]), bf_hi(mv[j]) * bf_hi(uv[j]));
      *(u32x4*)(p.mixcat + (size_t)(tok0 + t) * 1024 + hh * 128 + c * 8) = o;
    }
  }
}

DI void attn_core(const Params& p, int bb, int hh, int qt, int ktb, int kte, char* smem, f32x16 (&O)[4], float& m_out, float& l_out) {
  const int tid = ltid(), lane = tid & 63, w = tid >> 6, r = lane & 31, h = lane >> 5;
  const int map = w >> 1, qs = w & 1;
  const size_t tok0 = (size_t)bb * SEQ;
  const int q0 = qt * 64;
  const float slope2 = exp2f(-2.f * (float)(hh + 1)) * LOG2E;
  u32x4 qf[4];
  {
    const u16* qptr = p.qb + (tok0 + q0 + qs * 32 + r) * 512 + hh * 128 + map * 64 + 8 * h;
#pragma unroll
    for (int ks = 0; ks < 4; ++ks) qf[ks] = *(const u32x4*)(qptr + ks * 16);
  }
#pragma unroll
  for (int d = 0; d < 4; ++d)
#pragma unroll
    for (int i = 0; i < 16; ++i) O[d][i] = 0.f;
  float m = -1e30f, l = 0.f;
  const u16* kbase = p.kb + tok0 * 512 + hh * 128;
  const u16* vbase = p.vT + (size_t)(bb * 4 + hh) * 128 * SEQ;
  u32 koff[4], voff[4];
#pragma unroll
  for (int j = 0; j < 4; ++j) {
    const int krow = (w * 4 + j) * 4 + (lane >> 4);
    koff[j] = (u32)(krow * 512 + (((lane & 15) ^ (krow & 15)) << 3));
    const int vrow = (w * 4 + j) * 8 + (lane >> 3);
    voff[j] = (u32)(vrow * SEQ + (((lane & 7) ^ ((vrow >> 1) & 7)) << 3));
  }
  const int kr = (r & ~12) | ((r & 4) << 1) | ((r & 8) >> 1);
  const float hb = slope2 * (float)(8 * h);
  typedef __attribute__((address_space(1))) void gvoid;
  typedef __attribute__((address_space(3))) void lvoid;
  __syncthreads();
  {
    char* buf = smem + (ktb & 1) * 32768;
#pragma unroll
    for (int j = 0; j < 4; ++j) {
      __builtin_amdgcn_global_load_lds((const gvoid*)(kbase + (size_t)ktb * 64 * 512 + koff[j]), (lvoid*)(buf + (w * 4 + j) * 1024), 16, 0, 0);
      __builtin_amdgcn_global_load_lds((const gvoid*)(vbase + (size_t)ktb * 64 + voff[j]), (lvoid*)(buf + 16384 + (w * 4 + j) * 1024), 16, 0, 0);
    }
  }
  asm volatile("s_waitcnt vmcnt(0)" ::: "memory");
  __syncthreads();
  for (int kt = ktb; kt < kte; ++kt) {
    const char* buf = smem + (kt & 1) * 32768;
    if (kt + 1 < kte) {
      char* nb = smem + ((kt + 1) & 1) * 32768;
#pragma unroll
      for (int j = 0; j < 4; ++j) {
        __builtin_amdgcn_global_load_lds((const gvoid*)(kbase + (size_t)(kt + 1) * 64 * 512 + koff[j]), (lvoid*)(nb + (w * 4 + j) * 1024), 16, 0, 0);
        __builtin_amdgcn_global_load_lds((const gvoid*)(vbase + (size_t)(kt + 1) * 64 + voff[j]), (lvoid*)(nb + 16384 + (w * 4 + j) * 1024), 16, 0, 0);
      }
    }
    f32x16 S[2];
    {
      float hb2 = hb, sl = slope2;
      asm volatile("" : "+v"(hb2), "+v"(sl));
#pragma unroll
      for (int mt = 0; mt < 2; ++mt)
#pragma unroll
        for (int i = 0; i < 16; ++i) {
          if ((i & 7) == 0) S[mt][i] = hb2 + sl * (float)(32 * mt + 16 * (i >> 3));
          else S[mt][i] = S[mt][i - 1] + sl;
        }
    }
#pragma unroll
    for (int mt = 0; mt < 2; ++mt) {
      u32x4 af[4];
#pragma unroll
      for (int ks = 0; ks < 4; ++ks)
        af[ks] = *(const u32x4*)(buf + (mt * 32 + kr) * 256 + (((map * 8 + ks * 2 + h) ^ (kr & 15)) << 4));
#pragma unroll
      for (int ks = 0; ks < 4; ++ks) S[mt] = mfma32<false>(af[ks], qf[ks], S[mt]);
    }
    if (kt > ktb) m -= slope2 * 64.f;
    if (kt == qt) {
      const int qrel = qs * 32 + r;
#pragma unroll
      for (int mt = 0; mt < 2; ++mt)
#pragma unroll
        for (int i = 0; i < 16; ++i) {
          const int keyrel = 32 * mt + 16 * (i >> 3) + 8 * h + (i & 7);
          if (keyrel > qrel) S[mt][i] = -1e30f;
        }
    }
    float mx = S[0][0];
#pragma unroll
    for (int i = 1; i < 16; ++i) mx = fmaxf(mx, S[0][i]);
#pragma unroll
    for (int i = 0; i < 16; ++i) mx = fmaxf(mx, S[1][i]);
    mx = fmaxf(mx, __shfl_xor(mx, 32));
    if (__any(mx > m + 8.f)) {
      const float mn = fmaxf(m, mx);
      const float alpha = __builtin_amdgcn_exp2f(m - mn);
      m = mn;
      l *= alpha;
#pragma unroll
      for (int d = 0; d < 4; ++d)
#pragma unroll
        for (int i = 0; i < 16; ++i) O[d][i] *= alpha;
    }
    float ls = 0.f;
#pragma unroll
    for (int mt = 0; mt < 2; ++mt)
#pragma unroll
      for (int i = 0; i < 16; ++i) { const float e = __builtin_amdgcn_exp2f(S[mt][i] - m); S[mt][i] = e; ls += e; }
    l += ls;
#pragma unroll
    for (int mt = 0; mt < 2; ++mt)
#pragma unroll
      for (int s2 = 0; s2 < 2; ++s2) {
        u32x4 pf;
#pragma unroll
        for (int j = 0; j < 4; ++j) pf[j] = pack_bf2(S[mt][8 * s2 + 2 * j], S[mt][8 * s2 + 2 * j + 1]);
        u32x4 vf[4];
#pragma unroll
        for (int d = 0; d < 4; ++d)
          vf[d] = *(const u32x4*)(buf + 16384 + (d * 32 + r) * 128 + (((mt * 4 + s2 * 2 + h) ^ ((r >> 1) & 7)) << 4));
#pragma unroll
        for (int d = 0; d < 4; ++d) O[d] = mfma32<false>(vf[d], pf, O[d]);
      }
    asm volatile("s_waitcnt vmcnt(0)" ::: "memory");
    __syncthreads();
  }
  m_out = m; l_out = l;
}

DI void attn_finish(const Params& p, int bb, int hh, int qt, float lam, char* smem, f32x16 (&O)[4], float inv) {
  const int tid = ltid(), lane = tid & 63, w = tid >> 6, r = lane & 31, h = lane >> 5;
  const int map = w >> 1, qs = w & 1;
  const size_t tok0 = (size_t)bb * SEQ;
  const int q0 = qt * 64;
  __syncthreads();
  float* sC = (float*)smem;
  if (map == 1) {
    const float sc = inv * lam;
#pragma unroll
    for (int d = 0; d < 4; ++d)
#pragma unroll
      for (int i = 0; i < 16; ++i) sC[(qs * 64 + d * 16 + i) * 64 + lane] = O[d][i] * sc;
  }
  __syncthreads();
  if (map == 0) {
    float ss = 0.f;
#pragma unroll
    for (int d = 0; d < 4; ++d)
#pragma unroll
      for (int i = 0; i < 16; ++i) {
        const float v = O[d][i] * inv - sC[(qs * 64 + d * 16 + i) * 64 + lane];
        O[d][i] = v; ss += v * v;
      }
    ss += __shfl_xor(ss, 32);
    const float rs = rsqrtf(ss * (1.f / 128.f) + LN_EPS) * 0.8f;
    u16* dst = p.mixcat + (tok0 + q0 + qs * 32 + r) * 1024 + 512 + hh * 128;
#pragma unroll
    for (int d = 0; d < 4; ++d)
#pragma unroll
      for (int i4 = 0; i4 < 4; ++i4) {
        const int dv0 = d * 32 + 8 * i4 + 4 * h;
        const f32x4 g = *(const f32x4*)(p.da_g + hh * 128 + dv0);
        u32x2 o;
        o[0] = pack_bf2(O[d][4 * i4] * rs * g[0], O[d][4 * i4 + 1] * rs * g[1]);
        o[1] = pack_bf2(O[d][4 * i4 + 2] * rs * g[2], O[d][4 * i4 + 3] * rs * g[3]);
        *(u32x2*)(dst + dv0) = o;
      }
  }
}

typedef __attribute__((address_space(1))) u32 gu32;
#define RLX_AGENT __ATOMIC_RELAXED, __HIP_MEMORY_SCOPE_AGENT
constexpr size_t ATT_SLOT = 34816;

DI void attn_chunk(const Params& p, int bb, int hh, int qt, int ktb, int kte, int ch, int nch, float lam, char* smem, int* s_flag) {
  const int tid = ltid(), lane = tid & 63, w = tid >> 6;
  f32x16 O[4];
  float m, l;
  attn_core(p, bb, hh, qt, ktb, kte, smem, O, m, l);
  l += __shfl_xor(l, 32);
  if (nch == 1) { attn_finish(p, bb, hh, qt, lam, smem, O, 1.f / l); return; }
  const float slope2 = exp2f(-2.f * (float)(hh + 1)) * LOG2E;
  const int uidx = ((bb * 2 + (hh - 2)) * 128 + qt) * 4;
  {
    char* slot = p.part + (size_t)(uidx + ch) * ATT_SLOT;
    gu32* po = (gu32*)((u32*)slot + (size_t)w * 32 * 64 + lane);
    const float invl = 1.f / l;
#pragma unroll
    for (int d = 0; d < 4; ++d)
#pragma unroll
      for (int k = 0; k < 8; ++k) __hip_atomic_store(po + (d * 8 + k) * 64, pack_h2(O[d][2 * k] * invl, O[d][2 * k + 1] * invl), RLX_AGENT);
    gu32* pm = (gu32*)((u32*)(slot + 32768) + w * 128 + lane);
    __hip_atomic_store(pm, __float_as_uint(m + slope2 * 64.f * (float)(kte - 1)), RLX_AGENT);
    __hip_atomic_store(pm + 64, __float_as_uint(l), RLX_AGENT);
  }
  asm volatile("s_waitcnt vmcnt(0)" ::: "memory");
  __syncthreads();
  if (tid == 0) *s_flag = (int)__hip_atomic_fetch_add(p.stats + 64 + ((bb * 4 + hh) * 128 + qt), 1u, RLX_AGENT);
  __syncthreads();
  if (*s_flag != nch - 1) return;
  float mc[4], lc[4];
  float M = -1e30f;
#pragma unroll
  for (int c = 0; c < 4; ++c) {
    mc[c] = -1e30f; lc[c] = 0.f;
    if (c < nch) {
      gu32* pm = (gu32*)((u32*)(p.part + (size_t)(uidx + c) * ATT_SLOT + 32768) + w * 128 + lane);
      mc[c] = __uint_as_float(__hip_atomic_load(pm, RLX_AGENT)); lc[c] = __uint_as_float(__hip_atomic_load(pm + 64, RLX_AGENT));
      M = fmaxf(M, mc[c]);
    }
  }
#pragma unroll
  for (int d = 0; d < 4; ++d)
#pragma unroll
    for (int i = 0; i < 16; ++i) O[d][i] = 0.f;
  float lsum = 0.f;
#pragma unroll
  for (int c = 0; c < 4; ++c) {
    if (c < nch) {
      const float wc = lc[c] * __builtin_amdgcn_exp2f(mc[c] - M);
      lsum += wc;
      gu32* po = (gu32*)((u32*)(p.part + (size_t)(uidx + c) * ATT_SLOT) + (size_t)w * 32 * 64 + lane);
#pragma unroll
      for (int d = 0; d < 4; ++d)
#pragma unroll
        for (int k = 0; k < 8; ++k) {
          const u32 v = __hip_atomic_load(po + (d * 8 + k) * 64, RLX_AGENT);
          const h2_t hv = __builtin_bit_cast(h2_t, v);
          O[d][2 * k] += wc * (float)hv[0];
          O[d][2 * k + 1] += wc * (float)hv[1];
        }
    }
  }
  attn_finish(p, bb, hh, qt, lam, smem, O, 1.f / lsum);
}

DI void phase2(const Params& p, char* smem) {
  __shared__ int s_unit;
  __shared__ int s_flag;
  float lam;
  {
    float a = 0.f, b = 0.f;
    for (int i = 0; i < 64; ++i) { a += p.lq1[i] * p.lk1[i]; b += p.lq2[i] * p.lk2[i]; }
    lam = expf(a) - expf(b) + 0.2f;
  }
  for (;;) {
    __syncthreads();
    if (threadIdx.x == 0) s_unit = (int)atomicAdd(p.stats + 32, 1u);
    __syncthreads();
    const int u = s_unit;
    if (u >= 128 * 20 + 512) break;
    if (u < 128 * 20) {
      const int qt = 127 - u / 20, sidx = u % 20, bb = sidx / 10, wq = sidx % 10;
      const int hh = wq < 2 ? wq : (wq < 6 ? 2 : 3);
      const int ch = wq < 2 ? 0 : ((wq - 2) & 3);
      const int bh = bb * 4 + hh;
      const float q0m = __uint_as_float(p.stats[bh * 2]), q1m = __uint_as_float(p.stats[bh * 2 + 1]);
      const float k0m = __uint_as_float(p.stats[16 + bh * 2]), k1m = __uint_as_float(p.stats[16 + bh * 2 + 1]);
      const float B = 1.02f * fmaxf(sqrtf(q0m * k0m), sqrtf(q1m * k1m));
      const float slope2 = exp2f(-2.f * (float)(hh + 1)) * LOG2E;
      const float span = ((2.f * B + 45.f) / slope2 + 63.f) * (1.f / 64.f);
      int kt0 = 0;
      if (span < 200.f) { kt0 = qt - (int)span; if (kt0 < 0) kt0 = 0; }
      const int n = qt - kt0 + 1;
      int nch = 1;
      if (hh >= 2) nch = n > 48 ? 4 : (n > 20 ? 2 : 1);
      if (ch < nch) {
        const int len = (n + nch - 1) / nch;
        const int ktb = kt0 + ch * len;
        int kte = ktb + len; if (kte > qt + 1) kte = qt + 1;
        if (ktb < kte) attn_chunk(p, bb, hh, qt, ktb, kte, ch, nch, lam, smem, &s_flag);
        else if (nch > 1) {
          if (threadIdx.x == 0) atomicAdd(p.stats + 64 + (bh * 128 + qt), 1u);
        }
      }
    } else {
      const int g = u - 128 * 20;
      gmlp_unit(p, g >> 2, g & 3, smem);
    }
  }
}

DI void phase3(const Params& p, char* smem) {
  const int lane = threadIdx.x & 63, w = threadIdx.x >> 6, wm = w >> 1, wn = w & 1, r = lane & 31, h = lane >> 5;
  for (int t = blockIdx.x; t < 128 * 8; t += gridDim.x) {
    const int m0 = (t >> 3) * 128, n0 = (t & 7) * 128;
    f32x16 acc[2][2];
#pragma unroll
    for (int a = 0; a < 2; ++a)
#pragma unroll
      for (int b = 0; b < 2; ++b)
#pragma unroll
        for (int i = 0; i < 16; ++i) acc[a][b][i] = 0.f;
    gemm_tile<2, 2, false>(p.mixcat + (size_t)m0 * 1024, 1024, p.w_oT + (size_t)n0 * 1024, 1024, 1024, acc, smem);
    float* sC = (float*)smem;
#pragma unroll
    for (int half = 0; half < 2; ++half) {
      __syncthreads();
      if (wm == half) {
#pragma unroll
        for (int a = 0; a < 2; ++a)
#pragma unroll
          for (int b = 0; b < 2; ++b)
#pragma unroll
            for (int i = 0; i < 16; ++i) sC[(a * 32 + crow(i, h)) * 132 + wn * 64 + b * 32 + r] = acc[a][b][i];
      }
      __syncthreads();
#pragma unroll
      for (int i = 0; i < 8; ++i) {
        const int idx = threadIdx.x + 256 * i, t = idx >> 5, c = idx & 31;
        const f32x4 mv = *(const f32x4*)(sC + t * 132 + c * 4);
        const size_t o = (size_t)(m0 + half * 64 + t) * 1024 + n0 + c * 4;
        const u32x2 xq = *(const u32x2*)(p.xb + o);
        const float xv[4] = {bf_lo(xq[0]), bf_hi(xq[0]), bf_lo(xq[1]), bf_hi(xq[1])};
        f32x4 y;
#pragma unroll
        for (int j = 0; j < 4; ++j) y[j] = ALPHA * xv[j] + mv[j];
        u32x2 hv; hv[0] = pack_h2(y[0], y[1]); hv[1] = pack_h2(y[2], y[3]);
        *(u32x2*)((u16*)p.y1 + o) = hv;
      }
    }
  }
}

DI void phase3b(const Params& p) {
  const int lane = threadIdx.x & 63;
  const int gw = blockIdx.x * 4 + (threadIdx.x >> 6), nw = gridDim.x * 4;
  const u16* y1h = (const u16*)p.y1;
  for (int row = gw; row < T_TOK; row += nw) {
    const size_t ro = (size_t)row * 1024;
    float v[16];
    float s = 0.f;
#pragma unroll
    for (int i = 0; i < 2; ++i) {
      const h8_t hv = __builtin_bit_cast(h8_t, *(const u32x4*)(y1h + ro + i * 512 + lane * 8));
#pragma unroll
      for (int c = 0; c < 8; ++c) { v[i * 8 + c] = (float)hv[c]; s += v[i * 8 + c]; }
    }
    s = wave_sum(s);
    const float mu = s * (1.f / 1024.f);
    float q = 0.f;
#pragma unroll
    for (int i = 0; i < 16; ++i) { const float d = v[i] - mu; q += d * d; }
    q = wave_sum(q);
    const float rs = rsqrtf(q * (1.f / 1024.f) + LN_EPS);
#pragma unroll
    for (int i = 0; i < 2; ++i) {
      const int col = i * 512 + lane * 8;
      const f32x4 g0 = *(const f32x4*)(p.ln1g + col), g1 = *(const f32x4*)(p.ln1g + col + 4);
      const f32x4 b0 = *(const f32x4*)(p.ln1b + col), b1 = *(const f32x4*)(p.ln1b + col + 4);
      float y[8];
#pragma unroll
      for (int c = 0; c < 4; ++c) { y[c] = (v[i * 8 + c] - mu) * rs * g0[c] + b0[c]; y[4 + c] = (v[i * 8 + 4 + c] - mu) * rs * g1[c] + b1[c]; }
      u32x4 hv;
#pragma unroll
      for (int c = 0; c < 4; ++c) hv[c] = pack_h2(y[2 * c], y[2 * c + 1]);
      *(u32x4*)(p.x1h + ro + col) = hv;
    }
  }
}

DI u32 f2key(float f) { const u32 u = __float_as_uint(f); return (u & 0x80000000u) ? ~u : (u | 0x80000000u); }
DI float key2f(u32 k) { return __uint_as_float((k & 0x80000000u) ? (k & 0x7fffffffu) : ~k); }
DI u32 umax(u32 a, u32 b) { return a > b ? a : b; }
DI u32 umin(u32 a, u32 b) { return a < b ? a : b; }

DI void sort16_desc(u32 (&v)[16]) {
#pragma unroll
  for (int k = 2; k <= 16; k <<= 1)
#pragma unroll
    for (int j = k >> 1; j > 0; j >>= 1)
#pragma unroll
      for (int i = 0; i < 16; ++i) {
        const int l = i ^ j;
        if (l > i) {
          const u32 hi = umax(v[i], v[l]), lo = umin(v[i], v[l]);
          if ((i & k) == 0) { v[i] = hi; v[l] = lo; } else { v[i] = lo; v[l] = hi; }
        }
      }
}
DI void merge16_desc(u32 (&a)[16], const u32 (&b)[16]) {
#pragma unroll
  for (int i = 0; i < 16; ++i) a[i] = umax(a[i], b[15 - i]);
#pragma unroll
  for (int j = 8; j > 0; j >>= 1)
#pragma unroll
    for (int i = 0; i < 16; ++i) {
      const int l = i ^ j;
      if (l > i) { const u32 hi = umax(a[i], a[l]), lo = umin(a[i], a[l]); a[i] = hi; a[l] = lo; }
    }
}

DI void peer_route_unit(const Params& p, int tb, int head, char* smem) {
  const int tid = threadIdx.x, lane = tid & 63, w = tid >> 6, r = lane & 31, h = lane >> 5;
  const int tok0 = tb * 128;
  u32 top[2][16];
  f32x16 sc8[8];
#pragma unroll
  for (int mt = 0; mt < 8; ++mt)
#pragma unroll
    for (int i = 0; i < 16; ++i) sc8[mt][i] = 0.f;
  gemm_tile_n8<true>(p.w_qT + (size_t)(head * 256) * 1024, 1024, p.x1h + (size_t)tok0 * 1024, 1024, 1024, sc8, smem);
#pragma unroll
  for (int half = 0; half < 2; ++half) {
    f32x16 (&sc)[4] = *(f32x16 (*)[4])(&sc8[half * 4]);
    u32 kv[4][16];
#pragma unroll
    for (int mt = 0; mt < 4; ++mt) {
#pragma unroll
      for (int i = 0; i < 16; ++i) {
        const int key = mt * 32 + crow(i, h);
        kv[mt][i] = (f2key(sc[mt][i]) & ~127u) | (u32)(127 - key);
      }
      sort16_desc(kv[mt]);
    }
    merge16_desc(kv[0], kv[1]);
    merge16_desc(kv[2], kv[3]);
    merge16_desc(kv[0], kv[2]);
    u32 other[16];
#pragma unroll
    for (int i = 0; i < 16; ++i) other[i] = (u32)__shfl_xor((int)kv[0][i], 32);
    merge16_desc(kv[0], other);
#pragma unroll
    for (int i = 0; i < 16; ++i) top[half][i] = kv[0][i];
  }
  __syncthreads();
  int* sIdx = (int*)smem;
  float va[16], vb[16];
#pragma unroll
  for (int i = 0; i < 16; ++i) {
    va[i] = key2f(top[0][i] & ~127u); vb[i] = key2f(top[1][i] & ~127u);
    sIdx[tid * 33 + i] = 127 - (int)(top[0][i] & 127u);
    sIdx[tid * 33 + 16 + i] = 127 - (int)(top[1][i] & 127u);
  }
  u32 cd[4][16];
  {
    u32 c[64];
    int n = 0;
#pragma unroll
    for (int i = 0; i < 16; ++i)
#pragma unroll
      for (int j = 0; j < 16; ++j)
        if ((i + 1) * (j + 1) <= 16) { c[n] = (f2key(va[i] + vb[j]) & ~255u) | (u32)(255 - (i * 16 + j)); ++n; }
#pragma unroll
    for (int q = 50; q < 64; ++q) c[q] = 0u;
#pragma unroll
    for (int g = 0; g < 4; ++g)
#pragma unroll
      for (int i = 0; i < 16; ++i) cd[g][i] = c[g * 16 + i];
  }
#pragma unroll
  for (int g = 0; g < 4; ++g) sort16_desc(cd[g]);
  merge16_desc(cd[0], cd[1]);
  merge16_desc(cd[2], cd[3]);
  merge16_desc(cd[0], cd[2]);
  float sv[16], sum = 0.f;
  const float mx = key2f(cd[0][0] & ~255u);
#pragma unroll
  for (int i = 0; i < 16; ++i) { sv[i] = __expf(key2f(cd[0][i] & ~255u) - mx); sum += sv[i]; }
  const float inv = 1.f / sum;
  if (h == 0) {
    const size_t o = (size_t)(tok0 + w * 32 + r) * 128 + head * 16;
#pragma unroll
    for (int q = 0; q < 4; ++q) {
      int e[4]; f32x4 g;
#pragma unroll
      for (int c = 0; c < 4; ++c) {
        const int code = 255 - (int)(cd[0][q * 4 + c] & 255u);
        const int ea = sIdx[tid * 33 + (code >> 4)], eb = sIdx[tid * 33 + 16 + (code & 15)];
        g[c] = sv[q * 4 + c] * inv;
        e[c] = (int)(((u32)(ea * 128 + eb) << 18) | (u32)(g[c] * 262143.f + 0.5f));
      }
      *(u32x4*)(p.eid + o + q * 4) = (u32x4){(u32)e[0], (u32)e[1], (u32)e[2], (u32)e[3]};
    }
  }
  __syncthreads();
}

DI void phase4(const Params& p, char* smem) {
  for (int u = blockIdx.x; u < 1024; u += gridDim.x) {
#pragma unroll 2
    for (int i = threadIdx.x; i < 2048; i += 256) {
      const size_t i8 = (size_t)u * 2048 + i;
      cvt8_fp8(p.pu, (unsigned char*)p.u16t, i8, 512.f);
      cvt8_fp8(p.pv, (unsigned char*)p.v16t, i8, 64.f);
    }
    peer_route_unit(p, u >> 3, u & 7, smem);
  }
}

template <int CTRL, int ROWMASK>
DI float dpp_f(float v) {
  return __int_as_float(__builtin_amdgcn_update_dpp(0, __float_as_int(v), CTRL, ROWMASK, 0xF, false));
}
DI float dpp_sum_uniform(float v) {
  v += dpp_f<0xB1, 0xF>(v);
  v += dpp_f<0x4E, 0xF>(v);
  v += dpp_f<0x141, 0xF>(v);
  v += dpp_f<0x140, 0xF>(v);
  v += dpp_f<0x142, 0xA>(v);
  v += dpp_f<0x143, 0xC>(v);
  return __int_as_float(__builtin_amdgcn_readlane(__float_as_int(v), 63));
}
DI void sort128(u32& a, u32& b, int lane) {
#pragma unroll
  for (int k = 2; k <= 128; k <<= 1) {
#pragma unroll
    for (int j = k >> 1; j > 0; j >>= 1) {
      const bool up = ((2 * lane) & k) == 0;
      if (j == 1) {
        const u32 lo = umin(a, b), hi = umax(a, b);
        a = up ? lo : hi; b = up ? hi : lo;
      } else {
        const int m = j >> 1;
        const u32 oa = (u32)__shfl_xor((int)a, m), ob = (u32)__shfl_xor((int)b, m);
        const bool lower = (lane & m) == 0;
        a = (lower == up) ? umin(a, oa) : umax(a, oa);
        b = (lower == up) ? umin(b, ob) : umax(b, ob);
      }
    }
  }
}

constexpr int P5T = 4;
struct BatchU { u32x4 ru[8]; };
struct BatchV { u32x4 rv[8]; u32 pe[8]; };
struct P5Tabs { __amdgpu_buffer_rsrc_t ur, vr; };

DI u32 p5_entry(const u32 (&v0)[P5T], const u32 (&v1)[P5T], int i, int j) {
  const int st = j >> 2, t = j & 3;
  return (u32)__builtin_amdgcn_readlane((int)(st ? v1[t] : v0[t]), i);
}
DI void p5_issue_u(const P5Tabs& tb_, BatchU& bu, const u32 (&v0)[P5T], const u32 (&v1)[P5T], int i, int loff) {
#pragma unroll
  for (int j = 0; j < 8; ++j) {
    const u32 pe = p5_entry(v0, v1, i, j);
    bu.ru[j] = __builtin_bit_cast(u32x4, __builtin_amdgcn_raw_buffer_load_b128(tb_.ur, loff, (int)((pe >> 18) << 10), 0));
  }
}
DI void p5_issue_v(const P5Tabs& tb_, BatchV& bv, const u32 (&v0)[P5T], const u32 (&v1)[P5T], int i, int loff) {
#pragma unroll
  for (int j = 0; j < 8; ++j) {
    const u32 pe = p5_entry(v0, v1, i, j);
    bv.pe[j] = pe;
    bv.rv[j] = __builtin_bit_cast(u32x4, __builtin_amdgcn_raw_buffer_load_b128(tb_.vr, loff, (int)((pe >> 18) << 10), 0));
  }
}

template <int CTRL>
DI float dppx(float v) { return __int_as_float(__builtin_amdgcn_update_dpp(0, __float_as_int(v), CTRL, 0xF, 0xF, false)); }

DI float p5_dots(const BatchU& bu, const u32 (&pe)[8], const h2_t (&xh)[P5T][8], int lane) {
  float dv[8];
#pragma unroll
  for (int j = 0; j < 8; ++j) {
    const int t = j & 3;
    float d0 = 0.f, d1 = 0.f;
#pragma unroll
    for (int i = 0; i < 4; ++i) {
      const h2_t c0 = __builtin_amdgcn_cvt_scalef32_pk_f16_fp8((int)bu.ru[j][i], 1.0f, false);
      const h2_t c1 = __builtin_amdgcn_cvt_scalef32_pk_f16_fp8((int)bu.ru[j][i], 1.0f, true);
      d0 = __builtin_amdgcn_fdot2(c0, xh[t][2 * i], d0, false);
      d1 = __builtin_amdgcn_fdot2(c1, xh[t][2 * i + 1], d1, false);
    }
    dv[j] = d0 + d1;
  }
  const bool b0 = lane & 1, b1 = lane & 2, b2 = lane & 4;
  float r[4];
#pragma unroll
  for (int k = 0; k < 4; ++k) {
    const float z0 = b0 ? dv[2 * k + 1] : dv[2 * k], z1 = b0 ? dv[2 * k] : dv[2 * k + 1];
    r[k] = z0 + dppx<0xB1>(z1);
  }
  float q[2];
#pragma unroll
  for (int k = 0; k < 2; ++k) {
    const float z0 = b1 ? r[2 * k + 1] : r[2 * k], z1 = b1 ? r[2 * k] : r[2 * k + 1];
    q[k] = z0 + dppx<0x4E>(z1);
  }
  float tt;
  {
    const float z0 = b2 ? q[1] : q[0], z1 = b2 ? q[0] : q[1];
    tt = z0 + __int_as_float(__builtin_amdgcn_ds_swizzle(__float_as_int(z1), 0x101F));
  }
  tt += dppx<0x128>(tt);
  tt += __int_as_float(__builtin_amdgcn_ds_swizzle(__float_as_int(tt), 0x401F));
  tt += __shfl_xor(tt, 32);
  int gi = 0;
#pragma unroll
  for (int j = 0; j < 8; ++j) {
    const int gv = __builtin_amdgcn_readfirstlane((int)(pe[j] & 0x3FFFFu));
    asm volatile("v_writelane_b32 %0, %1, %2" : "+v"(gi) : "s"(gv), "i"(j));
  }
  return (float)gi * (1.f / (262143.f * 64.f)) * gelu_fast(tt * (1.f / 512.f));
}
DI void p5_accum(const BatchV& bv, float wv, f2_t (&acc)[P5T][8]) {
#pragma unroll
  for (int j = 0; j < 8; ++j) {
    const int t = j & 3;
    const float wgt = __int_as_float(__builtin_amdgcn_readlane(__float_as_int(wv), j));
    const f2_t w2 = {wgt, wgt};
#pragma unroll
    for (int i = 0; i < 4; ++i) {
      const f2_t lo = __builtin_amdgcn_cvt_pk_f32_fp8((int)bv.rv[j][i], false);
      const f2_t hi = __builtin_amdgcn_cvt_pk_f32_fp8((int)bv.rv[j][i], true);
      acc[t][2 * i] = lo * w2 + acc[t][2 * i];
      acc[t][2 * i + 1] = hi * w2 + acc[t][2 * i + 1];
    }
  }
}

DI void phase5(const Params& p) {
  const int lane = threadIdx.x & 63;
  const int gw = blockIdx.x * 4 + (threadIdx.x >> 6), nw = gridDim.x * 4;
  P5Tabs tabs;
  tabs.ur = __builtin_amdgcn_make_buffer_rsrc((void*)p.u16t, 0, 16 << 20, 0x00020000);
  tabs.vr = __builtin_amdgcn_make_buffer_rsrc((void*)p.v16t, 0, 16 << 20, 0x00020000);
  for (int tb = gw * P5T; tb < T_TOK; tb += nw * P5T) {
    h2_t xh[P5T][8];
    u32 v0[P5T], v1[P5T];
    f2_t acc[P5T][8];
    int lp = lane;
    asm volatile("" : "+v"(lp));
#pragma unroll
    for (int t = 0; t < P5T; ++t) {
      const u32x4* xr = (const u32x4*)(p.x1h + (size_t)(tb + t) * 1024 + lp * 16);
      const h8_t xa = __builtin_bit_cast(h8_t, xr[0]), xb = __builtin_bit_cast(h8_t, xr[1]);
#pragma unroll
      for (int i = 0; i < 4; ++i) { xh[t][i] = (h2_t){xa[2 * i], xa[2 * i + 1]}; xh[t][4 + i] = (h2_t){xb[2 * i], xb[2 * i + 1]}; }
      const size_t eo = (size_t)(tb + t) * 128 + 2 * lp;
      const u32x2 ent = *(const u32x2*)(p.eid + eo);
      u32 pa = ent[0], pb = ent[1];
      sort128(pa, pb, lp);
      v0[t] = pa; v1[t] = pb;
#pragma unroll
      for (int i = 0; i < 8; ++i) acc[t][i] = (f2_t){0.f, 0.f};
    }
    BatchU U;
    BatchV V;
    const int rev = ((tb / (nw * P5T)) & 1) ? 63 : 0;
    p5_issue_u(tabs, U, v0, v1, rev, lane * 16);
    p5_issue_v(tabs, V, v0, v1, rev, lane * 16);
#pragma unroll 1
    for (int i = 0; i < 64; ++i) {
      const float wv = p5_dots(U, V.pe, xh, lane);
      if (i + 1 < 64) p5_issue_u(tabs, U, v0, v1, rev ^ (i + 1), lane * 16);
      p5_accum(V, wv, acc);
      if (i + 1 < 64) p5_issue_v(tabs, V, v0, v1, rev ^ (i + 1), lane * 16);
    }
    int le = lane;
    asm volatile("" : "+v"(le));
#pragma unroll
    for (int t = 0; t < P5T; ++t) {
      asm volatile("" ::: "memory");
      float y[16];
      float sm = 0.f;
#pragma unroll
      for (int e = 0; e < 16; ++e) {
        y[e] = ALPHA * (float)xh[t][e >> 1][e & 1] + acc[t][e >> 1][e & 1];
        sm += y[e];
      }
      sm = wave_sum(sm);
      const float mu = sm * (1.f / 1024.f);
      float qv = 0.f;
#pragma unroll
      for (int i = 0; i < 16; ++i) { const float dd = y[i] - mu; qv += dd * dd; }
      qv = wave_sum(qv);
      const float rsd = rsqrtf(qv * (1.f / 1024.f) + LN_EPS);
#pragma unroll
      for (int q = 0; q < 4; ++q) {
        const int col = le * 16 + q * 4;
        const f32x4 g = *(const f32x4*)(p.ln2g + col), be = *(const f32x4*)(p.ln2b + col);
        f32x4 o;
#pragma unroll
        for (int c = 0; c < 4; ++c) o[c] = (y[q * 4 + c] - mu) * rsd * g[c] + be[c];
        *(f32x4*)(p.out + (size_t)(tb + t) * 1024 + col) = o;
      }
    }
  }
}

#define XB_TMO      128
#define XB_XCNT(j)  (256  + 64 * (j))
#define XB_XSUB(j)  (1280 + 64 * (j))
#define XB_XGEN(j)  (2304 + 64 * (j))
#define XB_TOP      3328
#define XB_TOPGEN   3392
#define XCD_BAR_WORDS 3456
#define XB_SPIN_CAP (1u << 18)
#define LAS __attribute__((address_space(3)))
DI unsigned xb_ld(unsigned* p) { return __hip_atomic_load(p, __ATOMIC_RELAXED, __HIP_MEMORY_SCOPE_AGENT); }
DI unsigned xb_add(unsigned* p, unsigned v) { return __hip_atomic_fetch_add(p, v, __ATOMIC_RELAXED, __HIP_MEMORY_SCOPE_AGENT); }
DI unsigned xb_xcc_id() { return (unsigned)__builtin_amdgcn_s_getreg((3 << 11) | 20) & 0xFu; }
#define XB_SPIN(cond, bar) do { unsigned _sp = 0; while (cond) { __builtin_amdgcn_s_sleep(1); \
    if ((++_sp & 255u) == 0u) { if (xb_ld(&(bar)[XB_TMO])) break; if (_sp > XB_SPIN_CAP) { atomicAdd(&(bar)[XB_TMO], 1u); break; } } } } while (0)
struct XcdBarrier { unsigned* bar; unsigned x; volatile LAS unsigned* st; };
DI XcdBarrier xcd_barrier_post(unsigned* bar, volatile LAS unsigned* st) {
  XcdBarrier b; b.bar = bar; b.x = xb_xcc_id(); b.st = st;
  if (threadIdx.x == 0) (void)xb_add(&bar[XB_XCNT(b.x)], 1u);
  return b;
}
DI void xcd_barrier_complete(unsigned* bar, unsigned x, unsigned& nloc, unsigned& nx) {
  const unsigned G = gridDim.x * gridDim.y * gridDim.z;
  unsigned sum, cnt, mine, sp = 0u;
  for (;;) {
    sum = 0u; cnt = 0u; mine = 0u;
#pragma unroll
    for (unsigned j = 0; j < 16; ++j) { const unsigned c = xb_ld(&bar[XB_XCNT(j)]); sum += c; cnt += (c > 0u) ? 1u : 0u; mine = (j == x) ? c : mine; }
    if (sum == G) break;
    __builtin_amdgcn_s_sleep(1);
    if ((++sp & 255u) == 0u) { if (xb_ld(&bar[XB_TMO])) break; if (sp > XB_SPIN_CAP) { atomicAdd(&bar[XB_TMO], 1u); break; } }
  }
  nloc = mine > 0u ? mine : 1u; nx = cnt > 0u ? cnt : 1u;
}
DI void xcd_barrier(const XcdBarrier& b) {
  asm volatile("s_waitcnt vmcnt(0)" ::: "memory");
  __syncthreads();
  if (threadIdx.x == 0) {
    unsigned* bar = b.bar;
    __builtin_amdgcn_s_waitcnt(0);
    unsigned nloc = b.st[0], nx = b.st[1];
    if (nloc == 0u) { xcd_barrier_complete(bar, b.x, nloc, nx); b.st[0] = nloc; b.st[1] = nx; }
    const unsigned old = xb_add(&bar[XB_XSUB(b.x)], 1u);
    const unsigned gen = old / nloc;
    if (old + 1u == (gen + 1u) * nloc) {
      __builtin_amdgcn_fence(__ATOMIC_RELEASE, "agent");
      asm volatile("s_waitcnt vmcnt(0)" ::: "memory");
      const unsigned og = xb_add(&bar[XB_TOP], 1u);
      const unsigned tg = og / nx;
      if (og + 1u == (tg + 1u) * nx) xb_add(&bar[XB_TOPGEN], 1u);
      else XB_SPIN(xb_ld(&bar[XB_TOPGEN]) == tg, bar);
      __builtin_amdgcn_fence(__ATOMIC_ACQUIRE, "agent");
      xb_add(&bar[XB_XGEN(b.x)], 1u);
      asm volatile("s_waitcnt vmcnt(0)" ::: "memory");
    } else {
      XB_SPIN(xb_ld(&bar[XB_XGEN(b.x)]) == gen, bar);
      __builtin_amdgcn_fence(__ATOMIC_ACQUIRE, "agent");
      asm volatile("s_waitcnt vmcnt(0)" ::: "memory");
    }
  }
  __syncthreads();
}

__global__ void __launch_bounds__(256, 2) mega(Params p, int lo, int hi) {
  __shared__ __attribute__((aligned(16))) char smem[65536];
  __shared__ uint4 xb_words;
  cg::grid_group grid = cg::this_grid();
  if (lo > 1000) grid.sync();
  if (threadIdx.x == 0) xb_words = make_uint4(0u, 0u, 0u, 0u);
  __syncthreads();
  XcdBarrier xb = xcd_barrier_post(p.bar, (volatile LAS unsigned*)&xb_words);
#ifndef ONLY_PHASE
#define ONLY_PHASE -1
#endif
#define RUNPH(n) (lo <= n && n < hi && (ONLY_PHASE < 0 || ONLY_PHASE == n))
#define SYNCPH(n) if (lo <= n && n + 1 < hi) xcd_barrier(xb);
  if (RUNPH(0)) phase0(p, smem);
  SYNCPH(0)
  if (RUNPH(1)) phase1(p, smem);
  SYNCPH(1)
  if (RUNPH(2)) phase2(p, smem);
  SYNCPH(2)
  if (RUNPH(3)) phase3(p, smem);
  SYNCPH(3)
  if (RUNPH(3)) phase3b(p);
  SYNCPH(3)
  if (RUNPH(4)) phase4(p, smem);
  SYNCPH(4)
  if (RUNPH(5)) phase5(p);
}

extern "C" void kernel_launch(void* const* d_in, const int* in_sizes, int n_in, void* d_out, int out_size, void* d_ws,
                              size_t ws_size, hipStream_t stream) {
  Params p{};
  const float** f = (const float**)&p;
  for (int i = 0; i < 21; ++i) f[i] = (const float*)d_in[i];
  p.out = (float*)d_out;
  char* ws = (char*)d_ws;
  size_t off = 0;
  auto take = [&](size_t bytes) { char* r = ws + off; off += (bytes + 255) & ~(size_t)255; return r; };
  const size_t MB = 1u << 20;
  char* X = take(64 * MB);
  p.xb = (u16*)X; p.mixcat = (u16*)(X + 32 * MB);
  p.x1f = (float*)X;
  p.u16t = (u16*)take(16 * MB);
  p.v16t = (u16*)take(16 * MB);
  char* R = take(80 * MB);
  p.zu = (u16*)R; p.zvT = (u16*)(R + 16 * MB); p.qb = (u16*)(R + 32 * MB); p.kb = (u16*)(R + 48 * MB); p.vT = (u16*)(R + 64 * MB);
  p.y1 = (float*)R;
  p.w_inT = (u16*)take(5 * MB);
  p.w_oT = (u16*)take(2 * MB);
  p.w_qT = (u16*)take(4 * MB);
  p.keysh = (u16*)take(512 * 1024);
  p.wsb = (u16*)take(128 * 1024);
  p.bar = (unsigned*)take((XCD_BAR_WORDS + 64 + 1024) * 4);
  p.stats = p.bar + XCD_BAR_WORDS;
  p.lnst = (float*)take((size_t)T_TOK * 2 * 4);
  const size_t tail0 = off;
  p.x1h = (u16*)take(32 * MB);
  p.eid = (int*)take(8 * MB);
  p.gate = (float*)take(8 * MB);
  p.part = (char*)ws + tail0;
  if (tail0 + (size_t)2048 * ATT_SLOT > off) off = tail0 + (size_t)2048 * ATT_SLOT;
  if (off > ws_size) { fprintf(stderr, "workspace too small: need %zu have %zu\n", off, ws_size); return; }
  static int grid_blocks = 0;
  if (!grid_blocks) {
    int dev = 0, cus = 0, per_cu = 0;
    hipGetDevice(&dev);
    hipDeviceGetAttribute(&cus, hipDeviceAttributeMultiprocessorCount, dev);
    hipOccupancyMaxActiveBlocksPerMultiprocessor(&per_cu, mega, 256, 0);
    if (per_cu > 2) per_cu = 2;
    grid_blocks = cus * per_cu;
  }
  hipMemsetAsync(p.bar, 0, (XCD_BAR_WORDS + 64 + 1024) * 4, stream);
#ifdef MULTI_LAUNCH
  for (int ph = 0; ph < 6; ++ph) hipLaunchKernelGGL(mega, dim3(grid_blocks), dim3(256), 0, stream, p, ph, ph + 1);
#else
  int lo = 0, hi = 6;
  void* args[] = {&p, &lo, &hi};
  hipError_t e = hipLaunchCooperativeKernel((void*)mega, dim3(grid_blocks), dim3(256), args, 0, stream);
  if (e != hipSuccess) fprintf(stderr, "cooperative launch failed: %s (grid %d)\n", hipGetErrorString(e), grid_blocks);
#endif
}
```
